# Optimizing an MI355X kernel written in HIP

```python
import math
import numpy as np
import jax
import jax.numpy as jnp
from jax import lax

D_MODEL = 2048
BATCH = 16
SEQ = 2048
DEPTH = 4

HEAD_DIM = 128
CONV_DIM = D_MODEL // 4
CONV_GROUPS = CONV_DIM // HEAD_DIM
GDN_HEADS = (D_MODEL - CONV_DIM) // (2 * HEAD_DIM)
NSA_HEADS = GDN_HEADS
GDN_DIM = GDN_HEADS * HEAD_DIM
NSA_DIM = NSA_HEADS * HEAD_DIM
NSA_KV_HEADS = 2
NSA_GROUP = NSA_HEADS // NSA_KV_HEADS
NSA_KV_DIM = 6 * NSA_KV_HEADS * HEAD_DIM
GDN_CONV_W = 4
GDN_CHUNK = 64
L_CMP = 32
D_CMP = 16
L_SLC = 64
TOP_N = 8
WINDOW = 512
Q_BLOCK = 128
SEL_Q_BLOCK = 64
NUM_BUCKETS = 32
MAX_DISTANCE = 128
SHORT_CONV_W = 3
D_FF = ((8 * D_MODEL // 3 + 255) // 256) * 256
PROJ_SIZES = (3 * GDN_DIM, GDN_DIM, GDN_HEADS, GDN_HEADS, NSA_DIM, NSA_KV_DIM, 3 * NSA_HEADS, CONV_DIM, CONV_DIM, CONV_DIM)
PROJ_DIM = sum(PROJ_SIZES)
RMS_EPS = 1e-6
FORCED_SCORE = 1e4

kernel_name = "hybrid_gdn_nsa_shortconv_trunk"


def rms_norm(x, g):
    xf = x.astype(jnp.float32)
    y = xf * lax.rsqrt(jnp.mean(xf * xf, axis=-1, keepdims=True) + RMS_EPS)
    return (y * g.astype(jnp.float32)).astype(x.dtype)


def l2_norm(x):
    return x * lax.rsqrt(jnp.sum(x * x, axis=-1, keepdims=True) + RMS_EPS)


def causal_depthwise_conv(x, w):
    S = x.shape[1]
    K = w.shape[-1]
    xp = jnp.pad(x, ((0, 0), (K - 1, 0), (0, 0)))
    y = xp[:, 0:S, :] * w[:, 0]
    for j in range(1, K):
        y = y + xp[:, j:j + S, :] * w[:, j]
    return y


def masked_softmax(logits, mask):
    logits = jnp.where(mask, logits, -jnp.inf)
    m = jnp.max(logits, axis=-1, keepdims=True)
    m = jnp.where(jnp.isfinite(m), m, 0.0)
    e = jnp.exp(logits - m)
    den = jnp.sum(e, axis=-1, keepdims=True)
    return e / jnp.where(den > 0, den, 1.0)


def t5_bucket(dist):
    n = jnp.maximum(dist, 0)
    max_exact = NUM_BUCKETS // 2
    nf = jnp.maximum(n, 1).astype(jnp.float32)
    large = max_exact + (jnp.log(nf / max_exact) / math.log(MAX_DISTANCE / max_exact) * (NUM_BUCKETS - max_exact)).astype(jnp.int32)
    large = jnp.minimum(large, NUM_BUCKETS - 1)
    return jnp.where(n < max_exact, n, large)


def head_bias(rel_bias, dist):
    b = rel_bias[t5_bucket(dist)].astype(jnp.float32)
    b = jnp.moveaxis(b, -1, 0)
    return b.reshape((NSA_KV_HEADS, NSA_GROUP) + dist.shape)


def gated_delta_rule_chunked(q, k, v, g, beta):
    B, H, S, dk = q.shape
    dv = v.shape[-1]
    C = GDN_CHUNK
    N = S // C
    q = q.reshape(B, H, N, C, dk)
    k = k.reshape(B, H, N, C, dk)
    v = v.reshape(B, H, N, C, dv)
    g = g.reshape(B, H, N, C)
    beta = beta.reshape(B, H, N, C)
    gc = jnp.cumsum(g, axis=-1)
    tril = jnp.asarray(np.tril(np.ones((C, C), dtype=bool)))
    strict = jnp.asarray(np.tril(np.ones((C, C), dtype=bool), -1))
    eye = jnp.eye(C, dtype=jnp.float32)
    diff = gc[..., :, None] - gc[..., None, :]
    decay = jnp.where(tril, jnp.exp(jnp.where(tril, diff, 0.0)), 0.0)
    kb = k * beta[..., None]
    vb = v * beta[..., None]
    L = jnp.where(strict, jnp.einsum('bhncd,bhnsd->bhncs', kb, k) * decay, 0.0)
    rhs = jnp.concatenate([vb, kb * jnp.exp(gc)[..., None]], axis=-1)
    sol = lax.linalg.triangular_solve(L + eye, rhs, left_side=True, lower=True, unit_diagonal=True)
    u = sol[..., :dv]
    w = sol[..., dv:]
    attn = jnp.where(tril, jnp.einsum('bhncd,bhnsd->bhncs', q, k) * decay, 0.0)

    def step(state, inp):
        q_i, k_i, u_i, w_i, gc_i, attn_i = inp
        v_new = u_i - jnp.einsum('bhcd,bhde->bhce', w_i, state)
        o = jnp.einsum('bhcd,bhde->bhce', q_i * jnp.exp(gc_i)[..., None], state) + jnp.einsum('bhcs,bhse->bhce', attn_i, v_new)
        g_last = gc_i[..., -1]
        k_dec = k_i * jnp.exp(g_last[..., None] - gc_i)[..., None]
        state = state * jnp.exp(g_last)[..., None, None] + jnp.einsum('bhcd,bhce->bhde', k_dec, v_new)
        return state, o

    xs = tuple(jnp.moveaxis(t, 2, 0) for t in (q, k, u, w, gc, attn))
    state0 = jnp.zeros((B, H, dk, dv), jnp.float32)
    _, o = lax.scan(step, state0, xs)
    return jnp.moveaxis(o, 0, 2).reshape(B, H, S, dv)


def gdn_mixer(qkv, z, b, a, conv_w, a_log, dt_bias, norm_g):
    B, S, _ = qkv.shape
    H, dk = GDN_HEADS, HEAD_DIM
    qkv = jax.nn.silu(causal_depthwise_conv(qkv, conv_w))
    q, k, v = [t.reshape(B, S, H, dk).transpose(0, 2, 1, 3).astype(jnp.float32) for t in jnp.split(qkv, 3, axis=-1)]
    q = l2_norm(q) * (dk ** -0.5)
    k = l2_norm(k)
    beta = jax.nn.sigmoid(b.astype(jnp.float32)).transpose(0, 2, 1)
    g = (-jnp.exp(a_log.astype(jnp.float32)) * jax.nn.softplus(a.astype(jnp.float32) + dt_bias.astype(jnp.float32))).transpose(0, 2, 1)
    o = gated_delta_rule_chunked(q, k, v, g, beta)
    o = o.transpose(0, 2, 1, 3).astype(z.dtype)
    o = rms_norm(o, norm_g) * jax.nn.silu(z.reshape(B, S, H, dk))
    return o.reshape(B, S, H * dk)


def nsa_mixer(q, kv, gates, q_norm, k_norm, cmp_pos, cmp_w1, cmp_w2, rel_bias):
    B, S, _ = q.shape
    H, Hkv, G, dk = NSA_HEADS, NSA_KV_HEADS, NSA_GROUP, HEAD_DIM
    scale = dk ** -0.5
    t = jnp.arange(S, dtype=jnp.int32)
    q = rms_norm(q.reshape(B, S, H, dk), q_norm)
    q = q.reshape(B, S, Hkv, G, dk).transpose(0, 2, 3, 1, 4)
    kv = kv.reshape(B, S, 6, Hkv, dk).transpose(2, 0, 3, 1, 4)
    k_cmp_tok, v_cmp_tok = kv[0], kv[1]
    k_slc, v_slc = rms_norm(kv[2], k_norm[1]), kv[3]
    k_win, v_win = rms_norm(kv[4], k_norm[2]), kv[5]

    n_cmp = (S - L_CMP) // D_CMP + 1
    cmp_start = np.arange(n_cmp) * D_CMP
    cmp_idx = cmp_start[:, None] + np.arange(L_CMP)[None, :]
    cmp_end = jnp.asarray(cmp_start + L_CMP - 1, dtype=jnp.int32)

    def compress(tok, pe, w1, w2):
        blk = tok[:, :, cmp_idx] + pe
        return jax.nn.silu(blk.reshape(B, Hkv, n_cmp, L_CMP * dk) @ w1) @ w2

    kc = rms_norm(compress(k_cmp_tok, cmp_pos[0], cmp_w1[0], cmp_w2[0]), k_norm[0])
    vc = compress(v_cmp_tok, cmp_pos[1], cmp_w1[1], cmp_w2[1])
    dist_c = t[:, None] - cmp_end[None, :]
    s_c = jnp.einsum('bhgtd,bhnd->bhgtn', q, kc).astype(jnp.float32) * scale + head_bias(rel_bias, dist_c)
    p_c = masked_softmax(s_c, dist_c >= 0)
    o_cmp = jnp.einsum('bhgtn,bhnd->bhgtd', p_c.astype(vc.dtype), vc)

    n_sel = S // L_SLC
    top_n = min(TOP_N, n_sel)
    sel_start = np.arange(n_sel) * L_SLC
    overlap = ((cmp_start[:, None] < sel_start[None, :] + L_SLC) & (cmp_start[:, None] + L_CMP > sel_start[None, :])).astype(np.float32)
    imp = jnp.einsum('bhgtn,nj->bhtj', p_c, jnp.asarray(overlap))
    cur = t // L_SLC
    j = jnp.arange(n_sel, dtype=jnp.int32)
    future = j[None, :] > cur[:, None]
    forced = (j[None, :] == 0) | (j[None, :] == cur[:, None]) | (j[None, :] == cur[:, None] - 1)
    imp = jnp.where(future, -1.0, jnp.where(forced, FORCED_SCORE, imp))
    _, sel_idx = lax.top_k(imp, top_n)
    sel_idx = sel_idx.astype(jnp.int32)

    nq = S // SEL_Q_BLOCK
    kb = k_slc.reshape(B * Hkv * n_sel, L_SLC, dk)
    vb = v_slc.reshape(B * Hkv * n_sel, L_SLC, dk)
    base = (jnp.arange(B * Hkv, dtype=jnp.int32) * n_sel).reshape(B, Hkv, 1, 1)
    flat = base + sel_idx
    q_ch = q.reshape(B, Hkv, G, nq, SEL_Q_BLOCK, dk).transpose(3, 0, 1, 2, 4, 5)
    flat_ch = flat.reshape(B, Hkv, nq, SEL_Q_BLOCK, top_n).transpose(2, 0, 1, 3, 4)
    sel_ch = sel_idx.reshape(B, Hkv, nq, SEL_Q_BLOCK, top_n).transpose(2, 0, 1, 3, 4)
    t_ch = t.reshape(nq, SEL_Q_BLOCK)
    tab = rel_bias.T.reshape(Hkv, G, NUM_BUCKETS)
    M = top_n * L_SLC

    def bias_lookup(tab_h, bk_h):
        return jnp.moveaxis(tab_h[:, bk_h], 0, 1)

    def sel_block(args):
        qc, fc, sc, tc = args
        kg = kb[fc].reshape(B, Hkv, SEL_Q_BLOCK, M, dk)
        vg = vb[fc].reshape(B, Hkv, SEL_Q_BLOCK, M, dk)
        pos = (sc[..., None] * L_SLC + jnp.arange(L_SLC, dtype=jnp.int32)).reshape(B, Hkv, SEL_Q_BLOCK, M)
        dist = tc[None, None, :, None] - pos
        bias = jax.vmap(bias_lookup, in_axes=(0, 1), out_axes=1)(tab, t5_bucket(dist))
        s = jnp.einsum('bhgqd,bhqmd->bhgqm', qc, kg).astype(jnp.float32) * scale + bias.astype(jnp.float32)
        p = masked_softmax(s, (dist >= 0)[:, :, None])
        return jnp.einsum('bhgqm,bhqmd->bhgqd', p.astype(vg.dtype), vg)

    o_slc = lax.map(sel_block, (q_ch, flat_ch, sel_ch, t_ch))
    o_slc = o_slc.transpose(1, 2, 3, 0, 4, 5).reshape(B, Hkv, G, S, dk)

    nb = S // Q_BLOCK
    span = Q_BLOCK + WINDOW
    band_idx = np.arange(nb)[:, None] * Q_BLOCK + np.arange(span)[None, :]
    pad = ((0, 0), (0, 0), (WINDOW, 0), (0, 0))
    kw = jnp.pad(k_win, pad)[:, :, band_idx]
    vw = jnp.pad(v_win, pad)[:, :, band_idx]
    dist_w = jnp.asarray(WINDOW + np.arange(Q_BLOCK)[:, None] - np.arange(span)[None, :], dtype=jnp.int32)
    key_pos = jnp.asarray(band_idx - WINDOW)
    mask_w = ((dist_w >= 0) & (dist_w < WINDOW))[None] & (key_pos >= 0)[:, None, :]
    bias_w = head_bias(rel_bias, dist_w)[:, :, None]
    qw = q.reshape(B, Hkv, G, nb, Q_BLOCK, dk)
    s_w = jnp.einsum('bhgiqd,bhikd->bhgiqk', qw, kw).astype(jnp.float32) * scale + bias_w
    p_w = masked_softmax(s_w, mask_w)
    o_win = jnp.einsum('bhgiqk,bhikd->bhgiqd', p_w.astype(vw.dtype), vw).reshape(B, Hkv, G, S, dk)

    gt = jax.nn.sigmoid(gates.reshape(B, S, 3, Hkv, G)).transpose(2, 0, 3, 4, 1)[..., None]
    o = gt[0] * o_cmp + gt[1] * o_slc + gt[2] * o_win
    return o.transpose(0, 3, 1, 2, 4).reshape(B, S, H * dk)


def short_conv_mixer(u, b, c, w):
    return b * causal_depthwise_conv(c * u, w)


def setup_inputs(seed: int = 0) -> dict:
    key = jax.random.key(seed)
    ks = jax.random.split(key, 20)
    f32 = jnp.float32

    def nrm(k, shape, fan_in):
        return jax.random.normal(k, shape, f32) * (fan_in ** -0.5)

    def gain(k, shape):
        return 1.0 + 0.01 * jax.random.normal(k, shape, f32)

    x = jax.random.normal(ks[0], (BATCH, SEQ, D_MODEL), f32)
    rel_bias = 0.2 * jax.random.normal(ks[1], (NUM_BUCKETS, NSA_HEADS), f32)
    norm_mix = gain(ks[2], (DEPTH, D_MODEL))
    w_in = nrm(ks[3], (DEPTH, D_MODEL, PROJ_DIM), D_MODEL)
    gdn_conv = nrm(ks[4], (DEPTH, 3 * GDN_DIM, GDN_CONV_W), GDN_CONV_W)
    gdn_a_log = jnp.log(jax.random.uniform(ks[5], (DEPTH, GDN_HEADS), f32, 1.0, 16.0))
    dt = jnp.exp(jax.random.uniform(ks[6], (DEPTH, GDN_HEADS), f32, math.log(1e-3), math.log(1e-1)))
    gdn_dt_bias = dt + jnp.log(-jnp.expm1(-dt))
    gdn_norm = gain(ks[7], (DEPTH, HEAD_DIM))
    nsa_q_norm = gain(ks[8], (DEPTH, HEAD_DIM))
    nsa_k_norm = gain(ks[9], (DEPTH, 3, HEAD_DIM))
    cmp_pos = 0.02 * jax.random.normal(ks[10], (DEPTH, 2, L_CMP, HEAD_DIM), f32)
    cmp_w1 = nrm(ks[11], (DEPTH, 2, L_CMP * HEAD_DIM, HEAD_DIM), L_CMP * HEAD_DIM)
    cmp_w2 = nrm(ks[12], (DEPTH, 2, HEAD_DIM, HEAD_DIM), HEAD_DIM)
    sconv_w = nrm(ks[13], (DEPTH, CONV_DIM, SHORT_CONV_W), SHORT_CONV_W)
    w_out = nrm(ks[14], (DEPTH, D_MODEL, D_MODEL), D_MODEL)
    norm_ffn = gain(ks[15], (DEPTH, D_MODEL))
    w_gate = nrm(ks[16], (DEPTH, D_MODEL, D_FF), D_MODEL)
    w_up = nrm(ks[17], (DEPTH, D_MODEL, D_FF), D_MODEL)
    w_down = nrm(ks[18], (DEPTH, D_FF, D_MODEL), D_FF)
    return {"x": x, "rel_bias": rel_bias, "norm_mix": norm_mix, "w_in": w_in, "gdn_conv": gdn_conv,
            "gdn_a_log": gdn_a_log, "gdn_dt_bias": gdn_dt_bias, "gdn_norm": gdn_norm,
            "nsa_q_norm": nsa_q_norm, "nsa_k_norm": nsa_k_norm, "cmp_pos": cmp_pos, "cmp_w1": cmp_w1,
            "cmp_w2": cmp_w2, "sconv_w": sconv_w, "w_out": w_out, "norm_ffn": norm_ffn,
            "w_gate": w_gate, "w_up": w_up, "w_down": w_down}


def reference(x, rel_bias, norm_mix, w_in, gdn_conv, gdn_a_log, gdn_dt_bias, gdn_norm, nsa_q_norm, nsa_k_norm,
              cmp_pos, cmp_w1, cmp_w2, sconv_w, w_out, norm_ffn, w_gate, w_up, w_down):
    splits = np.cumsum(PROJ_SIZES)[:-1].tolist()
    for l in range(DEPTH):
        h = rms_norm(x, norm_mix[l])
        proj = h @ w_in[l]
        (gdn_qkv, gdn_z, gdn_b, gdn_a, nsa_q, nsa_kv, nsa_g, cu, cb, cc) = jnp.split(proj, splits, axis=-1)
        y_gdn = gdn_mixer(gdn_qkv, gdn_z, gdn_b, gdn_a, gdn_conv[l], gdn_a_log[l], gdn_dt_bias[l], gdn_norm[l])
        y_nsa = nsa_mixer(nsa_q, nsa_kv, nsa_g, nsa_q_norm[l], nsa_k_norm[l], cmp_pos[l], cmp_w1[l], cmp_w2[l], rel_bias)
        y_conv = short_conv_mixer(cu, cb, cc, sconv_w[l])
        x = x + jnp.concatenate([y_gdn, y_nsa, y_conv], axis=-1) @ w_out[l]
        h = rms_norm(x, norm_ffn[l])
        x = x + (jax.nn.silu(h @ w_gate[l]) * (h @ w_up[l])) @ w_down[l]
    return x
```

```cpp
#include <hip/hip_runtime.h>
#include <cstdio>
#include <cstdint>

#ifndef MK_ONE_LAUNCH
#define MK_ONE_LAUNCH 0
#endif

namespace pg8 {
#define PG8_LAS __attribute__((address_space(3)))
typedef unsigned short bf16_t;
typedef short bf16x8 __attribute__((ext_vector_type(8)));
typedef float f32x4 __attribute__((ext_vector_type(4)));
typedef unsigned u32x4 __attribute__((ext_vector_type(4)));
constexpr int BM = 256, BK = 64, HALF = 128, HTB = HALF * BK * 2, STAGE_BYTES = 8 * HTB, NXCD = 8, WGM = 8;

__host__ __device__ __forceinline__ int lds_byte(int r, int c) { const int st = (r >> 4) * 2 + (c >> 5), rr = r & 15, cc = c & 31, ob = rr * 64 + cc * 2; return st * 1024 + (ob ^ (((ob >> 9) & 1) << 5)); }
__host__ __device__ __forceinline__ void stage_rc(int b, int& R, int& C) { const int st = b / 1024, sb = b % 1024, swz = sb ^ (((sb >> 9) & 1) << 5); R = (st >> 1) * 16 + swz / 64; C = (st & 1) * 32 + (swz % 64) / 2; }
__host__ __device__ __forceinline__ int perm32(int rho) { const int n = rho >> 4, i = rho & 15; return 8 * (i >> 2) + 4 * n + (i & 3); }

struct Unit { int pm, pn; };
struct Gemm { const bf16_t* A; const bf16_t* Bt; int M, N, K; };

struct StaticOrder {
    int nM, nN, nwg, G, c;
    __host__ __device__ void init(int M, int N, int G_, int c_) { nM = M / BM; nN = N / BM; nwg = nM * nN; G = G_; c = c_; }
    __host__ __device__ bool next(int i, Unit& u) const {
        const long L = (long)i * G + c; if (L >= nwg) return false;
        int wgid = (int)L; { const int q = nwg / NXCD, r = nwg % NXCD, xcd = wgid % NXCD, off = wgid / NXCD; wgid = (xcd < r ? xcd * (q + 1) : r * (q + 1) + (xcd - r) * q) + off; }
        const int nig = WGM * nN, gid = wgid / nig, fm = gid * WGM, gsz = (nM - fm) < WGM ? (nM - fm) : WGM;
        u.pm = fm + ((wgid % nig) % gsz); u.pn = (wgid % nig) / gsz; return true;
    }
    __device__ __forceinline__ void a_ready(const Unit&) const {}
    __device__ __forceinline__ void done(const Unit&) const {}
};

__device__ __forceinline__ unsigned cvt_pk_bf16(float lo, float hi) { unsigned r; asm volatile("v_cvt_pk_bf16_f32 %0, %1, %2" : "=v"(r) : "v"(lo), "v"(hi)); return r; }

struct EpiBf16 {
    static constexpr bool PERM = true, AFTER_DRAIN = false;
    bf16_t* O; int ldc;
    __device__ __forceinline__ void operator()(const f32x4 (&acc)[2][2][4][2], const Unit& u, int wr, int wc, int fr, int fq) const {
        const int row0 = u.pm * BM + wr * 64 + fr; const int col0 = u.pn * BM + wc * 32 + 8 * fq;
#pragma unroll
        for (int ai = 0; ai < 2; ++ai)
#pragma unroll
            for (int m = 0; m < 4; ++m) { bf16_t* rowp = O + (size_t)(row0 + ai * HALF + m * 16) * ldc + col0;
#pragma unroll
                for (int bj = 0; bj < 2; ++bj) { const f32x4 v0 = acc[ai][bj][m][0], v1 = acc[ai][bj][m][1];
                    u32x4 w; w.x = cvt_pk_bf16(v0[0], v0[1]); w.y = cvt_pk_bf16(v0[2], v0[3]); w.z = cvt_pk_bf16(v1[0], v1[1]); w.w = cvt_pk_bf16(v1[2], v1[3]);
                    *(u32x4*)(rowp + bj * HALF) = w; } }
    }
};
struct EpiResF32 {
    static constexpr bool PERM = false, AFTER_DRAIN = false;
    const float* base; float* out; int ldc;
    __device__ __forceinline__ void operator()(const f32x4 (&acc)[2][2][4][2], const Unit& u, int wr, int wc, int fr, int fq) const {
        const int row0 = u.pm * BM + wr * 64 + fr, col0 = u.pn * BM + wc * 32 + 4 * fq;
#pragma unroll
        for (int ai = 0; ai < 2; ++ai)
#pragma unroll
            for (int m = 0; m < 4; ++m) { const size_t off = (size_t)(row0 + ai * HALF + m * 16) * ldc + col0;
#pragma unroll
                for (int bj = 0; bj < 2; ++bj)
#pragma unroll
                    for (int n = 0; n < 2; ++n) { const f32x4 b = *(const f32x4*)(base + off + bj * HALF + n * 16); *(f32x4*)(out + off + bj * HALF + n * 16) = b + acc[ai][bj][m][n]; } }
    }
};
__device__ __forceinline__ float silu_f(float x) { return x * __builtin_amdgcn_rcpf(1.0f + __expf(-x)); }
struct EpiSwiGLU {
    static constexpr bool PERM = true, AFTER_DRAIN = false;
    bf16_t* O; int ldc;
    __device__ __forceinline__ void operator()(const f32x4 (&acc)[2][2][4][2], const Unit& u, int wr, int wc, int fr, int fq) const {
        const int row0 = u.pm * BM + wr * 64 + fr; const int col0 = u.pn * HALF + wc * 32 + 8 * fq;
#pragma unroll
        for (int ai = 0; ai < 2; ++ai)
#pragma unroll
            for (int m = 0; m < 4; ++m) { bf16_t* rowp = O + (size_t)(row0 + ai * HALF + m * 16) * ldc + col0;
                const f32x4 g0 = acc[ai][0][m][0], g1 = acc[ai][0][m][1], u0 = acc[ai][1][m][0], u1 = acc[ai][1][m][1];
                float r[8];
#pragma unroll
                for (int j = 0; j < 4; ++j) { r[j] = silu_f(g0[j]) * u0[j]; r[4 + j] = silu_f(g1[j]) * u1[j]; }
                u32x4 w; w.x = cvt_pk_bf16(r[0], r[1]); w.y = cvt_pk_bf16(r[2], r[3]); w.z = cvt_pk_bf16(r[4], r[5]); w.w = cvt_pk_bf16(r[6], r[7]);
                *(u32x4*)rowp = w; }
    }
};

template <class Epi, class Sched, bool ALIGN_EPI = false, bool SP2 = false>
__device__ __forceinline__ void gemm_phase(PG8_LAS unsigned char* lds, const Gemm g, const Sched& S, const Epi& E) {
    int tid_ = threadIdx.x; asm volatile("" : "+v"(tid_));
    const int tid = tid_, wid = __builtin_amdgcn_readfirstlane(tid >> 6), lane = tid & 63, wr = wid >> 2, wc = wid & 3, fr = lane & 15, fq = lane >> 4;
    const int K = g.K, nt = K / BK;
    unsigned voffA[2], voffB[2];
#pragma unroll
    for (int i = 0; i < 2; ++i) { int R, C; stage_rc(tid * 16 + i * 8192, R, C); const int Rb = Epi::PERM ? ((R & ~31) + perm32(R & 31)) : R;
        voffA[i] = (unsigned)(R * K + C) * 2u; voffB[i] = (unsigned)(Rb * K + C) * 2u; }
    const size_t kstep = (size_t)(BK * 2);
    const size_t hstep = (size_t)HALF * K * 2;
    const size_t tstep = 2 * hstep;
    const unsigned ldsw = (unsigned)wid * 1024u;
    const int aoff = lds_byte(wr * 64 + fr, fq * 8), boff = lds_byte(wc * 32 + fr, fq * 8);
#define PG8_SA(b, h) (((b) * 2 + (h)) * HTB)
#define PG8_SB(b, h) ((4 + (b) * 2 + (h)) * HTB)
#define PG8_STAGE(bufoff, gbase, voff) do { _Pragma("unroll") for (int _i = 0; _i < 2; ++_i) \
        __builtin_amdgcn_global_load_lds((const unsigned*)((const char*)(gbase) + (voff)[_i]), (PG8_LAS unsigned*)(lds + (bufoff) + ldsw + _i * 8192), 16, 0, 0); } while (0)
#define PG8_LDA(dst, b, h) do { _Pragma("unroll") for (int m = 0; m < 4; ++m) _Pragma("unroll") for (int k = 0; k < 2; ++k) dst[m][k] = *(const PG8_LAS bf16x8*)(lds + PG8_SA(b, h) + aoff + m * 2048 + k * 1024); } while (0)
#define PG8_LDB(dst, b, h) do { _Pragma("unroll") for (int n = 0; n < 2; ++n) _Pragma("unroll") for (int k = 0; k < 2; ++k) dst[n][k] = *(const PG8_LAS bf16x8*)(lds + PG8_SB(b, h) + boff + n * 2048 + k * 1024); } while (0)
#define PG8_MMA(ai, bj, At, Bt) do { __builtin_amdgcn_s_setprio(1); _Pragma("unroll") for (int m = 0; m < 4; ++m) _Pragma("unroll") for (int n = 0; n < 2; ++n) _Pragma("unroll") for (int k = 0; k < 2; ++k) \
        acc[ai][bj][m][n] = __builtin_amdgcn_mfma_f32_16x16x32_bf16(Bt[n][k], At[m][k], acc[ai][bj][m][n], 0, 0, 0); __builtin_amdgcn_s_setprio(0); } while (0)
#define PG8_WAIT_V(n) asm volatile("s_waitcnt vmcnt(" #n ")" ::: "memory")
#define PG8_WAIT_L(n) asm volatile("s_waitcnt lgkmcnt(" #n ")" ::: "memory")
#define PG8_BAR __builtin_amdgcn_s_barrier()
#define PG8_SCHED __builtin_amdgcn_sched_barrier(0)
    Unit cur, nxt; int ui = 0;
    if (!S.next(0, cur)) return;
    f32x4 acc[2][2][4][2];
#pragma unroll
    for (int a = 0; a < 2; ++a)
#pragma unroll
        for (int b = 0; b < 2; ++b)
#pragma unroll
            for (int m = 0; m < 4; ++m)
#pragma unroll
                for (int n = 0; n < 2; ++n) acc[a][b][m][n] = (f32x4){0.f, 0.f, 0.f, 0.f};
    bf16x8 At[4][2], B0[2][2], B1[2][2];
    const char* cA = (const char*)g.A + (size_t)cur.pm * tstep; const char* cB = (const char*)g.Bt + (size_t)cur.pn * tstep;
    S.a_ready(cur);
    if constexpr (SP2) {
        PG8_STAGE(PG8_SB(0, 0), cB, voffB); PG8_STAGE(PG8_SB(0, 1), cB + hstep, voffB); PG8_STAGE(PG8_SA(0, 0), cA, voffA); PG8_STAGE(PG8_SA(0, 1), cA + hstep, voffA);
        if (wr == 1) PG8_BAR;
        PG8_WAIT_V(2); PG8_BAR;
        PG8_STAGE(PG8_SB(1, 0), cB + kstep, voffB); PG8_STAGE(PG8_SA(1, 0), cA + kstep, voffA); PG8_STAGE(PG8_SB(1, 1), cB + hstep + kstep, voffB);
        PG8_WAIT_V(6); PG8_BAR;
    } else {
        PG8_STAGE(PG8_SB(0, 0), cB, voffB); PG8_STAGE(PG8_SA(0, 0), cA, voffA); PG8_STAGE(PG8_SB(0, 1), cB + hstep, voffB); PG8_STAGE(PG8_SA(0, 1), cA + hstep, voffA);
        if (wr == 1) PG8_BAR;
        PG8_WAIT_V(4); PG8_BAR;
        PG8_STAGE(PG8_SB(1, 0), cB + kstep, voffB); PG8_STAGE(PG8_SA(1, 0), cA + kstep, voffA); PG8_STAGE(PG8_SB(1, 1), cB + hstep + kstep, voffB);
        PG8_WAIT_V(6); PG8_BAR;
    }
    for (;;) {
        const bool has_next = S.next(ui + 1, nxt);
        const char* nA = has_next ? (const char*)g.A + (size_t)nxt.pm * tstep : cA; const char* nB = has_next ? (const char*)g.Bt + (size_t)nxt.pn * tstep : cB;
        for (int t = 0; t < nt; t += 2) {
            const bool last = (t == nt - 2);
            const char* a1 = cA + (size_t)(t + 1) * kstep;
            const char* a2 = last ? nA : cA + (size_t)(t + 2) * kstep; const char* b2 = last ? nB : cB + (size_t)(t + 2) * kstep;
            const char* a3 = a2 + kstep; const char* b3 = b2 + kstep;
            if (last && has_next) S.a_ready(nxt);
            if constexpr (SP2) {
            PG8_LDB(B0, 0, 0); PG8_LDB(B1, 0, 1); PG8_SCHED; PG8_LDA(At, 0, 0); PG8_STAGE(PG8_SA(1, 1), a1 + hstep, voffA);
            PG8_WAIT_V(8); PG8_WAIT_L(0); PG8_BAR; PG8_MMA(0, 0, At, B0); PG8_MMA(0, 1, At, B1); PG8_BAR; PG8_SCHED;
            PG8_LDA(At, 0, 1); PG8_STAGE(PG8_SB(0, 0), b2, voffB); PG8_STAGE(PG8_SB(0, 1), b2 + hstep, voffB); PG8_STAGE(PG8_SA(0, 0), a2, voffA);
            PG8_WAIT_V(8); PG8_WAIT_L(0); PG8_BAR; PG8_MMA(1, 0, At, B0); PG8_MMA(1, 1, At, B1); PG8_BAR; PG8_SCHED;
            PG8_LDB(B0, 1, 0); PG8_LDB(B1, 1, 1); PG8_SCHED; PG8_LDA(At, 1, 0); PG8_STAGE(PG8_SA(0, 1), a2 + hstep, voffA);
            PG8_WAIT_V(8); PG8_WAIT_L(0); PG8_BAR; PG8_MMA(0, 0, At, B0); PG8_MMA(0, 1, At, B1); PG8_BAR; PG8_SCHED;
            PG8_LDA(At, 1, 1); PG8_STAGE(PG8_SB(1, 0), b3, voffB); PG8_STAGE(PG8_SB(1, 1), b3 + hstep, voffB); PG8_STAGE(PG8_SA(1, 0), a3, voffA);
            PG8_WAIT_V(8); PG8_WAIT_L(0); PG8_BAR; PG8_MMA(1, 0, At, B0); PG8_MMA(1, 1, At, B1); PG8_BAR; PG8_SCHED;
            } else {
            PG8_LDB(B0, 0, 0); PG8_SCHED; PG8_LDA(At, 0, 0); PG8_STAGE(PG8_SA(1, 1), a1 + hstep, voffA);
            PG8_WAIT_L(8); PG8_BAR; PG8_WAIT_L(0); PG8_MMA(0, 0, At, B0); PG8_BAR; PG8_SCHED;
            PG8_LDB(B1, 0, 1); PG8_STAGE(PG8_SB(0, 0), b2, voffB);
            PG8_BAR; PG8_WAIT_L(0); PG8_MMA(0, 1, At, B1); PG8_BAR;
            PG8_LDA(At, 0, 1); PG8_STAGE(PG8_SA(0, 0), a2, voffA);
            PG8_BAR; PG8_WAIT_L(0); PG8_MMA(1, 0, At, B0); PG8_BAR; PG8_SCHED;
            PG8_STAGE(PG8_SB(0, 1), b2 + hstep, voffB);
            PG8_WAIT_V(6); PG8_BAR; PG8_MMA(1, 1, At, B1); PG8_BAR;
            PG8_LDB(B0, 1, 0); PG8_SCHED; PG8_LDA(At, 1, 0); PG8_STAGE(PG8_SA(0, 1), a2 + hstep, voffA);
            PG8_WAIT_L(8); PG8_BAR; PG8_WAIT_L(0); PG8_MMA(0, 0, At, B0); PG8_BAR; PG8_SCHED;
            PG8_LDB(B1, 1, 1); PG8_STAGE(PG8_SB(1, 0), b3, voffB);
            PG8_BAR; PG8_WAIT_L(0); PG8_MMA(0, 1, At, B1); PG8_BAR;
            PG8_LDA(At, 1, 1); PG8_STAGE(PG8_SA(1, 0), a3, voffA);
            PG8_BAR; PG8_WAIT_L(0); PG8_MMA(1, 0, At, B0); PG8_BAR; PG8_SCHED;
            PG8_STAGE(PG8_SB(1, 1), b3 + hstep, voffB);
            PG8_WAIT_V(6); PG8_BAR; PG8_MMA(1, 1, At, B1); PG8_BAR;
            }
        }
        if constexpr (ALIGN_EPI) { if (wr == 0) PG8_BAR; }
        if constexpr (!Epi::AFTER_DRAIN) { E(acc, cur, wr, wc, fr, fq); S.done(cur); }
        if (!has_next) break;
#pragma unroll
        for (int a = 0; a < 2; ++a)
#pragma unroll
            for (int b = 0; b < 2; ++b)
#pragma unroll
                for (int m = 0; m < 4; ++m)
#pragma unroll
                    for (int n = 0; n < 2; ++n) acc[a][b][m][n] = (f32x4){0.f, 0.f, 0.f, 0.f};
        cur = nxt; cA = nA; cB = nB; ++ui;
        if constexpr (ALIGN_EPI) { if (wr == 1) PG8_BAR; }
    }
    PG8_WAIT_V(0);
    if constexpr (!ALIGN_EPI) { if (wr == 0) PG8_BAR; }
    PG8_BAR;
#undef PG8_SA
#undef PG8_SB
#undef PG8_STAGE
#undef PG8_LDA
#undef PG8_LDB
#undef PG8_MMA
#undef PG8_WAIT_V
#undef PG8_WAIT_L
#undef PG8_BAR
#undef PG8_SCHED
}
}

constexpr int NWAVES = 8;
constexpr int DM = 2048, NBATCH = 16, SEQ = 2048, MTOK = NBATCH * SEQ, DEPTH = 4;
constexpr int NPROJ = 7168, PROJ_ORIG = 6942, DFF = 5632, NGU = 2 * DFF;
constexpr int GH = 6, HD = 128, NHKV = 2, NCMP = 127;
constexpr int PC_GQKV = 0, PC_GZ = 2304, PC_NQ = 3072, PC_NKV = 3840, PC_CU = 5376, PC_CB = 5888, PC_CC = 6400, PC_GB = 6912, PC_GA = 6918, PC_NG = 6924;
constexpr float RMS_EPS = 1e-6f;
constexpr int NPHASE = 9;

constexpr size_t MiB = 1u << 20;
constexpr size_t WS_CTL = 0, CTL_ZERO_BYTES = 1 * MiB;
constexpr size_t WS_WIN = 2 * MiB, WS_WOUT = 30 * MiB, WS_WGU = 38 * MiB, WS_WDN = 82 * MiB;
constexpr size_t WS_H = 104 * MiB;
constexpr size_t WS_PROJ = 232 * MiB;
constexpr size_t WS_GQ = 680 * MiB, WS_GK = 728 * MiB, WS_GV = 776 * MiB;
constexpr size_t WS_GO = 824 * MiB;
constexpr size_t WS_KN = 920 * MiB;
constexpr size_t WS_KC = 952 * MiB;
constexpr size_t WS_GBG = 956 * MiB;
constexpr size_t WS_END = 958 * MiB;
constexpr int CW_TMO = 0, CW_BAR = 4096, CW_Q = 16384;

constexpr int RING_OFF = 0, RING_BYTES = 131072;
constexpr int LDSCTL_OFF = RING_BYTES, MISC_OFF = LDSCTL_OFF + 320, BTAB_OFF = LDSCTL_OFF + 1024;
constexpr int LDS_BYTES = 147456;

#define GAS __attribute__((address_space(1)))
#define LAS __attribute__((address_space(3)))
typedef unsigned short bf16;
typedef unsigned v4u __attribute__((ext_vector_type(4)));
typedef unsigned v2u __attribute__((ext_vector_type(2)));
typedef float f32x4 __attribute__((ext_vector_type(4)));
typedef GAS unsigned gu32;
#define RLX_AGENT __ATOMIC_RELAXED, __HIP_MEMORY_SCOPE_AGENT
#define LDS_WAIT() asm volatile("s_waitcnt lgkmcnt(0)" ::: "memory")
__device__ __forceinline__ unsigned f2bf(float f) { unsigned u = __builtin_bit_cast(unsigned, f); return (u + 0x7fffu + ((u >> 16) & 1u)) >> 16; }
__device__ __forceinline__ unsigned pk2(float lo, float hi) { return f2bf(lo) | (f2bf(hi) << 16); }
__device__ __forceinline__ float bflo(unsigned w) { return __uint_as_float(w << 16); }
__device__ __forceinline__ float bfhi(unsigned w) { return __uint_as_float(w & 0xffff0000u); }
__device__ __forceinline__ float bf2f(bf16 b) { return __uint_as_float(((unsigned)b) << 16); }
__device__ __forceinline__ float wave_sum(float v) {
#pragma unroll
    for (int o = 1; o < 64; o <<= 1) v += __shfl_xor(v, o);
    return v;
}
__device__ __forceinline__ float wave_max(float v) {
#pragma unroll
    for (int o = 1; o < 64; o <<= 1) v = fmaxf(v, __shfl_xor(v, o));
    return v;
}
__device__ __forceinline__ float sigmoid_f(float x) { return 1.0f / (1.0f + __expf(-x)); }
__device__ __forceinline__ float rl(float v, int l) { return __int_as_float(__builtin_amdgcn_readlane(__float_as_int(v), l)); }

__constant__ unsigned char T5B[128] = {0, 1, 2, 3, 4, 5, 6, 7, 8, 9, 10, 11, 12, 13, 14, 15, 16, 16, 16, 17, 17, 18, 18, 18, 19, 19, 19, 20, 20, 20, 20, 21, 21, 21, 21, 22, 22, 22, 22, 22, 23, 23, 23, 23, 23, 23, 24, 24, 24, 24, 24, 24, 25, 25, 25, 25, 25, 25, 25, 26, 26, 26, 26, 26, 26, 26, 26, 27, 27, 27, 27, 27, 27, 27, 27, 27, 27, 28, 28, 28, 28, 28, 28, 28, 28, 28, 28, 29, 29, 29, 29, 29, 29, 29, 29, 29, 29, 29, 29, 30, 30, 30, 30, 30, 30, 30, 30, 30, 30, 30, 30, 30, 30, 31, 31, 31, 31, 31, 31, 31, 31, 31, 31, 31, 31, 31, 31, 31};

#define XB_TMO      128
#define XB_XCNT(j)  (256  + 64 * (j))
#define XB_XSUB(j)  (1280 + 64 * (j))
#define XB_XGEN(j)  (2304 + 64 * (j))
#define XB_TOP      3328
#define XB_TOPGEN   3392
#define XCD_BAR_WORDS 3456
#define XB_SPIN_CAP (1u << 22)
__device__ __forceinline__ unsigned xb_ld(unsigned* p)              { return __hip_atomic_load(p, __ATOMIC_RELAXED, __HIP_MEMORY_SCOPE_AGENT); }
__device__ __forceinline__ unsigned xb_add(unsigned* p, unsigned v) { return __hip_atomic_fetch_add(p, v, __ATOMIC_RELAXED, __HIP_MEMORY_SCOPE_AGENT); }
__device__ __forceinline__ unsigned xb_xcc_id() { return (unsigned)__builtin_amdgcn_s_getreg((3 << 11) | 20) & 0xFu; }
#define XB_SPIN(cond, bar) do { unsigned _sp = 0; while (cond) { __builtin_amdgcn_s_sleep(1); \
    if ((++_sp & 255u) == 0u) { if (xb_ld(&(bar)[XB_TMO])) break; if (_sp > XB_SPIN_CAP) { atomicAdd(&(bar)[XB_TMO], 1u); break; } } } } while (0)
struct XcdBarrier { unsigned* bar; unsigned x; volatile LAS unsigned* st; };
__device__ __forceinline__ XcdBarrier xcd_barrier_post(unsigned* bar, volatile LAS unsigned* st) {
    XcdBarrier b; b.bar = bar; b.x = xb_xcc_id(); b.st = st;
    if (threadIdx.x == 0) (void)xb_add(&bar[XB_XCNT(b.x)], 1u);
    return b;
}
__device__ __forceinline__ void xcd_barrier_complete(unsigned* bar, unsigned x, unsigned& nloc, unsigned& nx) {
    const unsigned G = gridDim.x * gridDim.y * gridDim.z;
    unsigned sum, cnt, mine, sp = 0u;
    for (;;) {
        sum = 0u; cnt = 0u; mine = 0u;
#pragma unroll
        for (unsigned j = 0; j < 16; ++j) { const unsigned c = xb_ld(&bar[XB_XCNT(j)]); sum += c; cnt += (c > 0u) ? 1u : 0u; mine = (j == x) ? c : mine; }
        if (sum == G) break;
        __builtin_amdgcn_s_sleep(1);
        if ((++sp & 255u) == 0u) { if (xb_ld(&bar[XB_TMO])) break; if (sp > XB_SPIN_CAP) { atomicAdd(&bar[XB_TMO], 1u); break; } }
    }
    nloc = mine > 0u ? mine : 1u; nx = cnt > 0u ? cnt : 1u;
}
__device__ __forceinline__ void xcd_barrier(const XcdBarrier& b) {
    asm volatile("s_waitcnt vmcnt(0)" ::: "memory");
    __syncthreads();
    if (threadIdx.x == 0) {
        unsigned* bar = b.bar;
        __builtin_amdgcn_s_waitcnt(0);
        unsigned nloc = b.st[0], nx = b.st[1];
        if (nloc == 0u) { xcd_barrier_complete(bar, b.x, nloc, nx); b.st[0] = nloc; b.st[1] = nx; }
        const unsigned old = xb_add(&bar[XB_XSUB(b.x)], 1u);
        const unsigned gen = old / nloc;
        if (old + 1u == (gen + 1u) * nloc) {
            __builtin_amdgcn_fence(__ATOMIC_RELEASE, "agent");
            asm volatile("s_waitcnt vmcnt(0)" ::: "memory");
            const unsigned og = xb_add(&bar[XB_TOP], 1u);
            const unsigned tg = og / nx;
            if (og + 1u == (tg + 1u) * nx) xb_add(&bar[XB_TOPGEN], 1u);
            else XB_SPIN(xb_ld(&bar[XB_TOPGEN]) == tg, bar);
            __builtin_amdgcn_fence(__ATOMIC_ACQUIRE, "agent");
            xb_add(&bar[XB_XGEN(b.x)], 1u);
            asm volatile("s_waitcnt vmcnt(0)" ::: "memory");
        } else {
            XB_SPIN(xb_ld(&bar[XB_XGEN(b.x)]) == gen, bar);
            __builtin_amdgcn_fence(__ATOMIC_ACQUIRE, "agent");
            asm volatile("s_waitcnt vmcnt(0)" ::: "memory");
        }
    }
    __syncthreads();
}

struct Frame {
    LAS unsigned char* lds;
    gu32* ctl;
    int tid, lane, wave, vcu, G;
    const unsigned char* kp;
    float* out; unsigned char* ws;
    __device__ __forceinline__ const float* inp(int i) const { const unsigned char* p = kp; asm volatile("" : "+s"(p)); return ((const float* const*)p)[i]; }
};
enum { I_X = 0, I_RELB, I_NMIX, I_WIN, I_GCONV, I_GALOG, I_GDT, I_GNORM, I_NQN, I_NKN, I_CPOS, I_CW1, I_CW2, I_SCW, I_WOUT, I_NFFN, I_WG, I_WU, I_WD };

__device__ __forceinline__ void transpose_tile(const float* W, int ldw, int scol, bf16* WTrow0, int K, int k0, LAS float* scr, int lane) {
#pragma unroll 8
    for (int i = 0; i < 32; ++i) { const int kk = 2 * i + (lane >> 5); scr[kk * 33 + (lane & 31)] = scol >= 0 ? W[(size_t)(k0 + kk) * ldw + scol] : 0.f; }
    LDS_WAIT();
    const int c = lane & 7;
#pragma unroll
    for (int j = 0; j < 4; ++j) { const int n = (lane >> 3) + 8 * j; const LAS float* s = scr + (8 * c) * 33 + n;
        v4u o; o.x = pk2(s[0 * 33], s[1 * 33]); o.y = pk2(s[2 * 33], s[3 * 33]); o.z = pk2(s[4 * 33], s[5 * 33]); o.w = pk2(s[6 * 33], s[7 * 33]);
        *(GAS v4u*)(WTrow0 + (size_t)n * K + k0 + 8 * c) = o; }
    LDS_WAIT();
}
__device__ __forceinline__ int win_src(int n) {
    if (n < 3072) return n;
    if (n < 5376) return n + 12;
    if (n < 6912) return n + 30;
    if (n < 6924) return n - 6912 + 3072;
    if (n < 6942) return n - 6924 + 5388;
    return -1;
}
__device__ __forceinline__ void ph_convert(Frame& F, int l) {
    LAS float* scr = (LAS float*)(F.lds + RING_OFF + F.wave * 16384);
    const int gw = F.vcu * NWAVES + F.wave, NGW = F.G * NWAVES, lane = F.lane;
    constexpr int I_A = 32 * (NPROJ / 32), I_B = 32 * (DM / 32), I_C = 32 * (NGU / 32), I_D = (DFF / 64) * (DM / 32);
    bf16* WIN = (bf16*)(F.ws + WS_WIN); bf16* WOUT = (bf16*)(F.ws + WS_WOUT); bf16* WGU = (bf16*)(F.ws + WS_WGU); bf16* WDN = (bf16*)(F.ws + WS_WDN);
    for (int it = gw; it < I_A + I_B + I_C + I_D; it += NGW) {
        int r = it;
        if (r < I_A) { const int nblk = NPROJ / 32, kb = r / nblk, nb = r % nblk; const int sc = win_src(nb * 32 + (lane & 31));
            transpose_tile(F.inp(I_WIN) + (size_t)l * DM * PROJ_ORIG, PROJ_ORIG, sc, WIN + (size_t)(nb * 32) * DM, DM, kb * 64, scr, lane); continue; }
        r -= I_A;
        if (r < I_B) { const int nblk = DM / 32, kb = r / nblk, nb = r % nblk;
            transpose_tile(F.inp(I_WOUT) + (size_t)l * DM * DM, DM, nb * 32 + (lane & 31), WOUT + (size_t)(nb * 32) * DM, DM, kb * 64, scr, lane); continue; }
        r -= I_B;
        if (r < I_C) { const int nblk = NGU / 32, kb = r / nblk, nb = r % nblk; const int n0 = nb * 32, pn = n0 >> 8, rr = n0 & 255;
            const float* src = (rr < 128) ? F.inp(I_WG) : F.inp(I_WU);
            transpose_tile(src + (size_t)l * DM * DFF, DFF, pn * 128 + (rr & 127) + (lane & 31), WGU + (size_t)n0 * DM, DM, kb * 64, scr, lane); continue; }
        r -= I_C;
        { const int nblk = DM / 32, kb = r / nblk, nb = r % nblk;
            transpose_tile(F.inp(I_WD) + (size_t)l * DFF * DM, DM, nb * 32 + (lane & 31), WDN + (size_t)(nb * 32) * DFF, DFF, kb * 64, scr, lane); }
    }
}
__device__ __forceinline__ void rms_row(const float* xrow, const float* gain, bf16* orow, int lane) {
    const GAS f32x4* xr = (const GAS f32x4*)xrow + lane; const GAS f32x4* gr = (const GAS f32x4*)gain + lane;
    f32x4 v[8]; float s = 0.f;
#pragma unroll
    for (int j = 0; j < 8; ++j) { v[j] = xr[64 * j]; s += (v[j].x * v[j].x + v[j].y * v[j].y) + (v[j].z * v[j].z + v[j].w * v[j].w); }
    const float rs = 1.0f / sqrtf(wave_sum(s) * (1.f / DM) + RMS_EPS);
    GAS v2u* o8 = (GAS v2u*)orow + lane;
#pragma unroll
    for (int j = 0; j < 8; ++j) { const f32x4 g = gr[64 * j]; v2u w; w.x = pk2(v[j].x * rs * g.x, v[j].y * rs * g.y); w.y = pk2(v[j].z * rs * g.z, v[j].w * rs * g.w); o8[64 * j] = w; }
}
__device__ __forceinline__ void ph_norm(Frame& F, const float* x, const float* gain) {
    const int gw = F.vcu * NWAVES + F.wave, NGW = F.G * NWAVES; bf16* H = (bf16*)(F.ws + WS_H);
    for (int m = gw; m < MTOK; m += NGW) rms_row(x + (size_t)m * DM, gain, H + (size_t)m * DM, F.lane);
}

__device__ __forceinline__ float softplus_f(float x) { return x > 20.f ? x : log1pf(__expf(x)); }
__device__ __forceinline__ void ph_mix1(Frame& F, int l) {
    const int gw = F.vcu * NWAVES + F.wave, NGW = F.G * NWAVES, lane = F.lane;
    const bf16* P = (const bf16*)(F.ws + WS_PROJ);
    {
        bf16* GQ = (bf16*)(F.ws + WS_GQ); bf16* GK = (bf16*)(F.ws + WS_GK); bf16* GV = (bf16*)(F.ws + WS_GV);
        float* GB = (float*)(F.ws + WS_GBG); float* GG = GB + NBATCH * GH * SEQ;
        const float* cw = F.inp(I_GCONV) + (size_t)l * 2304 * 4;
        for (int it = gw; it < MTOK * GH; it += NGW) {
            const int m = it / GH, h = it % GH, b = m / SEQ, t = m % SEQ;
            float val[3][2];
#pragma unroll
            for (int p = 0; p < 3; ++p) {
                const int ch = p * 768 + h * 128 + 2 * lane;
                const f32x4 w0 = *(const f32x4*)(cw + (size_t)ch * 4), w1 = *(const f32x4*)(cw + (size_t)(ch + 1) * 4);
                float a0 = 0.f, a1 = 0.f;
#pragma unroll
                for (int j = 0; j < 4; ++j) { const int tt = t - 3 + j; if (tt >= 0) { const unsigned w = *(const unsigned*)(P + (size_t)(m - 3 + j) * NPROJ + PC_GQKV + ch); a0 += bflo(w) * w0[j]; a1 += bfhi(w) * w1[j]; } }
                val[p][0] = pg8::silu_f(a0); val[p][1] = pg8::silu_f(a1);
            }
            const float sq = wave_sum(val[0][0] * val[0][0] + val[0][1] * val[0][1]), sk = wave_sum(val[1][0] * val[1][0] + val[1][1] * val[1][1]);
            const float rq = (1.0f / sqrtf(sq + RMS_EPS)) * 0.08838834764831845f, rk = 1.0f / sqrtf(sk + RMS_EPS);
            const size_t o = ((size_t)(b * GH + h) * SEQ + t) * HD + 2 * lane;
            *(unsigned*)(GQ + o) = pk2(val[0][0] * rq, val[0][1] * rq);
            *(unsigned*)(GK + o) = pk2(val[1][0] * rk, val[1][1] * rk);
            *(unsigned*)(GV + o) = pk2(val[2][0], val[2][1]);
            if (lane == 0) {
                const float bb = bf2f(P[(size_t)m * NPROJ + PC_GB + h]), aa = bf2f(P[(size_t)m * NPROJ + PC_GA + h]);
                GB[(size_t)(b * GH + h) * SEQ + t] = sigmoid_f(bb);
                GG[(size_t)(b * GH + h) * SEQ + t] = -__expf(F.inp(I_GALOG)[l * GH + h]) * softplus_f(aa + F.inp(I_GDT)[l * GH + h]);
            }
        }
    }
    {
        bf16* KN = (bf16*)(F.ws + WS_KN);
        for (int it = gw; it < MTOK * 4; it += NGW) {
            const int m = it >> 2, which = (it >> 1) & 1, hkv = it & 1, b = m / SEQ, t = m % SEQ;
            const unsigned w = *(const unsigned*)(P + (size_t)m * NPROJ + PC_NKV + (2 + 2 * which) * 256 + hkv * 128 + 2 * lane);
            const float a0 = bflo(w), a1 = bfhi(w);
            const float rs = 1.0f / sqrtf(wave_sum(a0 * a0 + a1 * a1) * (1.f / HD) + RMS_EPS);
            const float* kn = F.inp(I_NKN) + (size_t)(l * 3 + 1 + which) * HD + 2 * lane;
            *(unsigned*)(KN + ((size_t)((which * NBATCH + b) * NHKV + hkv) * SEQ + t) * HD + 2 * lane) = pk2(a0 * rs * kn[0], a1 * rs * kn[1]);
        }
    }
    {
        bf16* Y = (bf16*)(F.ws + WS_H);
        const float* sw = F.inp(I_SCW) + (size_t)l * 512 * 3;
        for (int m = gw; m < MTOK; m += NGW) {
            const int t = m % SEQ; const int c0 = 8 * lane;
            float acc[8];
#pragma unroll
            for (int i = 0; i < 8; ++i) acc[i] = 0.f;
#pragma unroll
            for (int j = 0; j < 3; ++j) { const int tt = t - 2 + j; if (tt >= 0) {
                const v4u u = *(const v4u*)(P + (size_t)(m - 2 + j) * NPROJ + PC_CU + c0), c = *(const v4u*)(P + (size_t)(m - 2 + j) * NPROJ + PC_CC + c0);
#pragma unroll
                for (int i = 0; i < 4; ++i) { acc[2 * i] += bflo(u[i]) * bflo(c[i]) * sw[(c0 + 2 * i) * 3 + j]; acc[2 * i + 1] += bfhi(u[i]) * bfhi(c[i]) * sw[(c0 + 2 * i + 1) * 3 + j]; } } }
            const v4u bq = *(const v4u*)(P + (size_t)m * NPROJ + PC_CB + c0);
            v4u o;
#pragma unroll
            for (int i = 0; i < 4; ++i) o[i] = pk2(acc[2 * i] * bflo(bq[i]), acc[2 * i + 1] * bfhi(bq[i]));
            *(v4u*)(Y + (size_t)m * DM + 1536 + c0) = o;
        }
    }
    {
        LAS float* blk = (LAS float*)(F.lds + RING_OFF + F.wave * 16384);
        float* KC = (float*)(F.ws + WS_KC);
        for (int it = gw; it < 2 * NBATCH * NHKV * NCMP; it += NGW) {
            const int n = it % NCMP, r1 = it / NCMP, hkv = r1 % NHKV, r2 = r1 / NHKV, b = r2 % NBATCH, sel = r2 / NBATCH;
            const float* pe = F.inp(I_CPOS) + (size_t)(l * 2 + sel) * 32 * HD;
            const float* w1 = F.inp(I_CW1) + (size_t)(l * 2 + sel) * 4096 * HD;
            const float* w2 = F.inp(I_CW2) + (size_t)(l * 2 + sel) * HD * HD;
#pragma unroll 4
            for (int li = 0; li < 32; ++li) { const size_t m = (size_t)b * SEQ + 16 * n + li;
                const unsigned w = *(const unsigned*)(P + m * NPROJ + PC_NKV + sel * 256 + hkv * 128 + 2 * lane);
                blk[li * HD + 2 * lane] = bflo(w) + pe[li * HD + 2 * lane]; blk[li * HD + 2 * lane + 1] = bfhi(w) + pe[li * HD + 2 * lane + 1]; }
            LDS_WAIT();
            float h0 = 0.f, h1 = 0.f;
            for (int i = 0; i < 4096; i += 4) { const f32x4 a = *(const LAS f32x4*)(blk + i);
#pragma unroll
                for (int j = 0; j < 4; ++j) { h0 += a[j] * w1[(size_t)(i + j) * HD + lane]; h1 += a[j] * w1[(size_t)(i + j) * HD + 64 + lane]; } }
            LDS_WAIT();
            blk[lane] = pg8::silu_f(h0); blk[64 + lane] = pg8::silu_f(h1);
            LDS_WAIT();
            float o0 = 0.f, o1 = 0.f;
            for (int j = 0; j < HD; j += 4) { const f32x4 a = *(const LAS f32x4*)(blk + j);
#pragma unroll
                for (int q = 0; q < 4; ++q) { o0 += a[q] * w2[(size_t)(j + q) * HD + lane]; o1 += a[q] * w2[(size_t)(j + q) * HD + 64 + lane]; } }
            LDS_WAIT();
            if (sel == 0) { const float rs = 1.0f / sqrtf(wave_sum(o0 * o0 + o1 * o1) * (1.f / HD) + RMS_EPS); const float* kn = F.inp(I_NKN) + (size_t)(l * 3) * HD;
                o0 *= rs * kn[lane]; o1 *= rs * kn[64 + lane]; }
            float* dst = KC + ((size_t)((sel * NBATCH + b) * NHKV + hkv) * NCMP + n) * HD;
            dst[lane] = o0; dst[64 + lane] = o1;
        }
    }
}

__device__ __forceinline__ void gdn_recur_unit(Frame& F, int u) {
    const int bh = u >> 1, half = u & 1, b = bh / GH, h = bh % GH, lane = F.lane;
    const bf16* Q = (const bf16*)(F.ws + WS_GQ) + (size_t)bh * SEQ * HD; const bf16* K = (const bf16*)(F.ws + WS_GK) + (size_t)bh * SEQ * HD; const bf16* V = (const bf16*)(F.ws + WS_GV) + (size_t)bh * SEQ * HD;
    const float* GB = (const float*)(F.ws + WS_GBG) + (size_t)bh * SEQ; const float* GG = GB + NBATCH * GH * SEQ;
    float* O = (float*)(F.ws + WS_GO) + (size_t)b * SEQ * 768 + h * HD + half * 64 + lane;
    float S[HD];
#pragma unroll
    for (int d = 0; d < HD; ++d) S[d] = 0.f;
    float nk0 = bf2f(K[lane]), nk1 = bf2f(K[64 + lane]), nq0 = bf2f(Q[lane]), nq1 = bf2f(Q[64 + lane]), nv = bf2f(V[half * 64 + lane]), nb = GB[0], ng = GG[0];
    for (int t = 0; t < SEQ; ++t) {
        const float k0 = nk0, k1 = nk1, q0 = nq0, q1 = nq1, v = nv, beta = nb, a = __expf(ng);
        if (t + 1 < SEQ) { const size_t o = (size_t)(t + 1) * HD; nk0 = bf2f(K[o + lane]); nk1 = bf2f(K[o + 64 + lane]); nq0 = bf2f(Q[o + lane]); nq1 = bf2f(Q[o + 64 + lane]); nv = bf2f(V[o + half * 64 + lane]); nb = GB[t + 1]; ng = GG[t + 1]; }
        float acc = 0.f;
#pragma unroll
        for (int d = 0; d < 64; ++d) acc += rl(k0, d) * S[d];
#pragma unroll
        for (int d = 0; d < 64; ++d) acc += rl(k1, d) * S[64 + d];
        const float vn = beta * (v - a * acc);
        float o = 0.f;
#pragma unroll
        for (int d = 0; d < 64; ++d) { S[d] = rl(k0, d) * vn + a * S[d]; o += rl(q0, d) * S[d]; }
#pragma unroll
        for (int d = 0; d < 64; ++d) { S[64 + d] = rl(k1, d) * vn + a * S[64 + d]; o += rl(q1, d) * S[64 + d]; }
        O[(size_t)t * 768] = o;
    }
}
__device__ __forceinline__ void attn8(const LAS float* qs, const bf16* Kb, const bf16* Vb, int ldv, const int (&pos0)[8], int nch, int t, const LAS float* btab, int lane, float& o0, float& o1) {
    float s[8];
#pragma unroll
    for (int c = 0; c < 8; ++c) {
        s[c] = -__builtin_inff();
        if (c < nch) {
            const int pos = pos0[c] + lane; const bool valid = pos >= 0 && pos <= t; const int pc = pos < 0 ? 0 : (pos > SEQ - 1 ? SEQ - 1 : pos);
            const v4u* kr = (const v4u*)(Kb + (size_t)pc * HD); float dot = 0.f;
#pragma unroll 4
            for (int d8 = 0; d8 < 16; ++d8) { const v4u kw = kr[d8]; const f32x4 qa = *(const LAS f32x4*)(qs + d8 * 8), qb = *(const LAS f32x4*)(qs + d8 * 8 + 4);
                dot += bflo(kw.x) * qa.x + bfhi(kw.x) * qa.y + bflo(kw.y) * qa.z + bfhi(kw.y) * qa.w + bflo(kw.z) * qb.x + bfhi(kw.z) * qb.y + bflo(kw.w) * qb.z + bfhi(kw.w) * qb.w; }
            const int dist = t - pos; const int di = dist < 0 ? 0 : (dist > 128 ? 128 : dist);
            if (valid) s[c] = dot + btab[di];
        }
    }
    float mx = s[0];
#pragma unroll
    for (int c = 1; c < 8; ++c) mx = fmaxf(mx, s[c]);
    mx = wave_max(mx);
    float sum = 0.f;
#pragma unroll
    for (int c = 0; c < 8; ++c) { s[c] = __expf(s[c] - mx); sum += s[c]; }
    sum = wave_sum(sum);
    const float inv = 1.0f / sum;
    float a0 = 0.f, a1 = 0.f;
#pragma unroll
    for (int c = 0; c < 8; ++c) {
        if (c < nch) {
            for (int kk = 0; kk < 64; ++kk) { const float p = rl(s[c], kk); int pos = pos0[c] + kk; pos = pos < 0 ? 0 : (pos > SEQ - 1 ? SEQ - 1 : pos);
                const unsigned w = *(const unsigned*)(Vb + (size_t)pos * ldv + 2 * lane); a0 += p * bflo(w); a1 += p * bfhi(w); }
        }
    }
    o0 = a0 * inv; o1 = a1 * inv;
}
__device__ __forceinline__ void nsa_row_unit(Frame& F, int l, int item, LAS float* wl, const LAS float* btab) {
    const int t = item % SEQ, r1 = item / SEQ, hkv = r1 % NHKV, b = r1 / NHKV, lane = F.lane; const size_t m = (size_t)b * SEQ + t;
    const bf16* P = (const bf16*)(F.ws + WS_PROJ);
    LAS float* qs = wl;
    LAS float* pc = wl + 384;
    LAS float* ps = wl + 512;
    const float* KC = (const float*)(F.ws + WS_KC) + (size_t)((0 * NBATCH + b) * NHKV + hkv) * NCMP * HD;
    const float* VC = (const float*)(F.ws + WS_KC) + (size_t)((1 * NBATCH + b) * NHKV + hkv) * NCMP * HD;
#pragma unroll
    for (int g = 0; g < 3; ++g) { const int h = hkv * 3 + g;
        const unsigned w = *(const unsigned*)(P + m * NPROJ + PC_NQ + h * HD + 2 * lane); const float a0 = bflo(w), a1 = bfhi(w);
        const float rs = (1.0f / sqrtf(wave_sum(a0 * a0 + a1 * a1) * (1.f / HD) + RMS_EPS)) * 0.08838834764831845f; const float* qn = F.inp(I_NQN) + (size_t)l * HD + 2 * lane;
        qs[g * HD + 2 * lane] = a0 * rs * qn[0]; qs[g * HD + 2 * lane + 1] = a1 * rs * qn[1]; }
    LDS_WAIT();
    const int nvalid = t < 31 ? 0 : ((t - 31) >> 4) + 1;
    float ocmp[3][2]; float psum0 = 0.f, psum1 = 0.f;
#pragma unroll
    for (int g = 0; g < 3; ++g) { const int h = hkv * 3 + g; const LAS float* bt = btab + h * 132;
        float s0 = -__builtin_inff(), s1 = -__builtin_inff();
        if (lane < nvalid) { const float* kr = KC + (size_t)lane * HD; float dot = 0.f;
            for (int d = 0; d < HD; d += 4) { const f32x4 kv = *(const f32x4*)(kr + d); const f32x4 qv = *(const LAS f32x4*)(qs + g * HD + d); dot += kv.x * qv.x + kv.y * qv.y + kv.z * qv.z + kv.w * qv.w; }
            const int dist = t - 16 * lane - 31; s0 = dot + bt[dist > 128 ? 128 : dist]; }
        if (lane + 64 < nvalid) { const float* kr = KC + (size_t)(lane + 64) * HD; float dot = 0.f;
            for (int d = 0; d < HD; d += 4) { const f32x4 kv = *(const f32x4*)(kr + d); const f32x4 qv = *(const LAS f32x4*)(qs + g * HD + d); dot += kv.x * qv.x + kv.y * qv.y + kv.z * qv.z + kv.w * qv.w; }
            const int dist = t - 16 * (lane + 64) - 31; s1 = dot + bt[dist > 128 ? 128 : dist]; }
        float p0 = 0.f, p1 = 0.f;
        if (nvalid > 0) { const float mx = wave_max(fmaxf(s0, s1)); p0 = __expf(s0 - mx); p1 = __expf(s1 - mx); const float inv = 1.0f / wave_sum(p0 + p1); p0 *= inv; p1 *= inv; }
        psum0 += p0; psum1 += p1;
        pc[lane] = p0; pc[64 + lane] = p1;
        LDS_WAIT();
        float a0 = 0.f, a1 = 0.f;
        for (int n = 0; n < nvalid; ++n) { const float p = pc[n]; const float2 v = *(const float2*)(VC + (size_t)n * HD + 2 * lane); a0 += p * v.x; a1 += p * v.y; }
        ocmp[g][0] = a0; ocmp[g][1] = a1;
        LDS_WAIT();
    }
    ps[1 + lane] = psum0; ps[65 + lane] = (lane + 64 < NCMP) ? psum1 : 0.f; if (lane == 0) { ps[0] = 0.f; ps[129] = 0.f; ps[130] = 0.f; ps[131] = 0.f; }
    LDS_WAIT();
    const int cur = t >> 6;
    float val = -3.0e38f;
    if (lane < 32) { const int j = lane; const float imp = ps[4 * j] + ps[4 * j + 1] + ps[4 * j + 2] + ps[4 * j + 3] + ps[4 * j + 4];
        val = (j > cur) ? -1.0f : ((j == 0 || j == cur || j == cur - 1) ? 1.0e4f : imp); }
    unsigned selmask = 0u;
#pragma unroll 1
    for (int it = 0; it < 8; ++it) { const float mx = wave_max(val); const unsigned long long bal = __ballot(val == mx); const int jsel = __builtin_ctzll(bal);
        selmask |= 1u << jsel; if (lane == jsel) val = -3.0e38f; }
    LDS_WAIT();
    int spos[8]; int nsel = 0;
    { unsigned mk = selmask & ((cur >= 31) ? 0xffffffffu : ((1u << (cur + 1)) - 1u));
#pragma unroll
      for (int c = 0; c < 8; ++c) { if (mk) { const int j = __builtin_ctz(mk); mk &= mk - 1u; spos[c] = 64 * j; nsel = c + 1; } else spos[c] = 0; } }
    int wpos[8];
#pragma unroll
    for (int c = 0; c < 8; ++c) wpos[c] = t - 511 + 64 * c;
    const bf16* KS = (const bf16*)(F.ws + WS_KN) + (size_t)((0 * NBATCH + b) * NHKV + hkv) * SEQ * HD;
    const bf16* KW = (const bf16*)(F.ws + WS_KN) + (size_t)((1 * NBATCH + b) * NHKV + hkv) * SEQ * HD;
    const bf16* VS = P + (size_t)b * SEQ * NPROJ + PC_NKV + 3 * 256 + hkv * 128;
    const bf16* VW = P + (size_t)b * SEQ * NPROJ + PC_NKV + 5 * 256 + hkv * 128;
    bf16* Y = (bf16*)(F.ws + WS_H);
#pragma unroll 1
    for (int g = 0; g < 3; ++g) { const int h = hkv * 3 + g; const LAS float* bt = btab + h * 132;
        float s0, s1, w0, w1;
        attn8(qs + g * HD, KS, VS, NPROJ, spos, nsel, t, bt, lane, s0, s1);
        attn8(qs + g * HD, KW, VW, NPROJ, wpos, 8, t, bt, lane, w0, w1);
        const float g0 = sigmoid_f(bf2f(P[m * NPROJ + PC_NG + 0 * 6 + h])), g1 = sigmoid_f(bf2f(P[m * NPROJ + PC_NG + 1 * 6 + h])), g2 = sigmoid_f(bf2f(P[m * NPROJ + PC_NG + 2 * 6 + h]));
        const float c0 = (g == 0 ? ocmp[0][0] : (g == 1 ? ocmp[1][0] : ocmp[2][0])), c1 = (g == 0 ? ocmp[0][1] : (g == 1 ? ocmp[1][1] : ocmp[2][1]));
        *(unsigned*)(Y + m * DM + 768 + h * HD + 2 * lane) = pk2(g0 * c0 + g1 * s0 + g2 * w0, g0 * c1 + g1 * s1 + g2 * w1);
    }
    LDS_WAIT();
}
__device__ __forceinline__ void ph_mix2(Frame& F, int l) {
    LAS float* btab = (LAS float*)(F.lds + BTAB_OFF);
    for (int i = F.tid; i < 6 * 132; i += NWAVES * 64) { const int h = i / 132, d = i % 132; btab[i] = F.inp(I_RELB)[(d < 128 ? (int)T5B[d] : 31) * 6 + h]; }
    __syncthreads();
    if (F.wave == 0 && (int)blockIdx.x < 192) gdn_recur_unit(F, (int)blockIdx.x);
    LAS float* wl = (LAS float*)(F.lds + RING_OFF + F.wave * 16384);
    gu32* qctr = F.ctl + CW_Q + 64 * l;
    for (;;) {
        int item = 0;
        if (F.lane == 0) item = (int)__hip_atomic_fetch_add(qctr, 1u, RLX_AGENT);
        item = __builtin_amdgcn_readfirstlane(item);
        if (item >= NBATCH * NHKV * SEQ) break;
        nsa_row_unit(F, l, item, wl, btab);
    }
}
__device__ __forceinline__ void ph_mix3(Frame& F, int l) {
    const int gw = F.vcu * NWAVES + F.wave, NGW = F.G * NWAVES, lane = F.lane;
    const bf16* P = (const bf16*)(F.ws + WS_PROJ); const float* GO = (const float*)(F.ws + WS_GO); bf16* Y = (bf16*)(F.ws + WS_H);
    const float* gn = F.inp(I_GNORM) + (size_t)l * HD + 2 * lane;
    for (int it = gw; it < MTOK * GH; it += NGW) { const int m = it / GH, h = it % GH;
        const float2 o = *(const float2*)(GO + (size_t)m * 768 + h * HD + 2 * lane);
        const float rs = 1.0f / sqrtf(wave_sum(o.x * o.x + o.y * o.y) * (1.f / HD) + RMS_EPS);
        const unsigned zw = *(const unsigned*)(P + (size_t)m * NPROJ + PC_GZ + h * HD + 2 * lane);
        *(unsigned*)(Y + (size_t)m * DM + h * HD + 2 * lane) = pk2(o.x * rs * gn[0] * pg8::silu_f(bflo(zw)), o.y * rs * gn[1] * pg8::silu_f(bfhi(zw)));
    }
}

struct Args { const float* in[19]; float* out; unsigned char* ws; int l_lo, l_hi, ph_lo, ph_hi; };
__global__ void __launch_bounds__(NWAVES * 64, 2) trunk_fwd(Args args) {
    extern __shared__ __attribute__((aligned(16))) unsigned char lds[];
    Frame F;
    F.lds = (LAS unsigned char*)lds;
    F.tid = threadIdx.x; F.lane = F.tid & 63; F.wave = __builtin_amdgcn_readfirstlane(F.tid >> 6);
    F.G = gridDim.x; { const int bx = blockIdx.x; F.vcu = (F.G % 8 == 0) ? (bx % 8) * (F.G / 8) + bx / 8 : bx; }
    F.kp = (const unsigned char*)__builtin_amdgcn_kernarg_segment_ptr(); F.ws = args.ws; F.ctl = (gu32*)(args.ws + WS_CTL); F.out = args.out;
    for (int u = F.tid; u < (LDS_BYTES - LDSCTL_OFF) / 4; u += NWAVES * 64) ((LAS unsigned*)(F.lds + LDSCTL_OFF))[u] = 0u;
    __syncthreads();
#if MK_ONE_LAUNCH
    XcdBarrier bar = xcd_barrier_post((unsigned*)(F.ctl + CW_BAR), (volatile LAS unsigned*)(F.lds + MISC_OFF) + 8);
#define GRID_BAR() xcd_barrier(bar)
#else
#define GRID_BAR() do {} while (0)
#endif
    bf16* WIN = (bf16*)(F.ws + WS_WIN); bf16* WOUT = (bf16*)(F.ws + WS_WOUT); bf16* WGU = (bf16*)(F.ws + WS_WGU); bf16* WDN = (bf16*)(F.ws + WS_WDN);
    bf16* H = (bf16*)(F.ws + WS_H); bf16* PROJ = (bf16*)(F.ws + WS_PROJ);
    for (int l = args.l_lo; l < args.l_hi; ++l) {
        { int t_ = threadIdx.x; asm volatile("" : "+v"(t_)); F.tid = t_; F.lane = t_ & 63; }
        const float* xin = (l == 0) ? F.inp(I_X) : F.out;
#define IN(k) (args.ph_lo <= (k) && (k) < args.ph_hi)
        if (IN(0)) { ph_convert(F, l); ph_norm(F, xin, F.inp(I_NMIX) + (size_t)l * DM); GRID_BAR(); }
        if (IN(1)) { pg8::Gemm g{H, WIN, MTOK, NPROJ, DM}; pg8::StaticOrder S; S.init(MTOK, NPROJ, F.G, (int)blockIdx.x); pg8::EpiBf16 E{PROJ, NPROJ};
            pg8::gemm_phase<pg8::EpiBf16, pg8::StaticOrder, true, true>(F.lds + RING_OFF, g, S, E); GRID_BAR(); }
        if (IN(2)) { ph_mix1(F, l); GRID_BAR(); }
        if (IN(3)) { ph_mix2(F, l); GRID_BAR(); }
        if (IN(4)) { ph_mix3(F, l); GRID_BAR(); }
        if (IN(5)) { pg8::Gemm g{H, WOUT, MTOK, DM, DM}; pg8::StaticOrder S; S.init(MTOK, DM, F.G, (int)blockIdx.x); pg8::EpiResF32 E{xin, F.out, DM};
            pg8::gemm_phase<pg8::EpiResF32, pg8::StaticOrder, true, true>(F.lds + RING_OFF, g, S, E); GRID_BAR(); }
        if (IN(6)) { ph_norm(F, F.out, F.inp(I_NFFN) + (size_t)l * DM); GRID_BAR(); }
        if (IN(7)) { pg8::Gemm g{H, WGU, MTOK, NGU, DM}; pg8::StaticOrder S; S.init(MTOK, NGU, F.G, (int)blockIdx.x); pg8::EpiSwiGLU E{PROJ, DFF};
            pg8::gemm_phase<pg8::EpiSwiGLU, pg8::StaticOrder, true, true>(F.lds + RING_OFF, g, S, E); GRID_BAR(); }
        if (IN(8)) { pg8::Gemm g{PROJ, WDN, MTOK, DM, DFF}; pg8::StaticOrder S; S.init(MTOK, DM, F.G, (int)blockIdx.x); pg8::EpiResF32 E{F.out, F.out, DM};
            pg8::gemm_phase<pg8::EpiResF32, pg8::StaticOrder, true, true>(F.lds + RING_OFF, g, S, E); if (l + 1 < args.l_hi) GRID_BAR(); }
#undef IN
    }
}

extern "C" void kernel_launch(void* const* d_in, const int* in_sizes, int n_in, void* d_out, int out_size, void* d_ws, size_t ws_size, hipStream_t stream) {
    static int grid = 0;
    if (grid == 0) {
        if (n_in != 19 || in_sizes[0] != MTOK * DM || out_size != MTOK * DM || ws_size < WS_END) { fprintf(stderr, "kernel_launch: unexpected shapes (n_in %d, in0 %d, out %d, ws %zu); nothing launched\n", n_in, n_in > 0 ? in_sizes[0] : -1, out_size, ws_size); grid = -1; return; }
        int dev = 0, cus = 0;
        if (hipGetDevice(&dev) != hipSuccess || hipDeviceGetAttribute(&cus, hipDeviceAttributeMultiprocessorCount, dev) != hipSuccess) { grid = -1; return; }
        if (hipFuncSetAttribute((const void*)trunk_fwd, hipFuncAttributeMaxDynamicSharedMemorySize, LDS_BYTES) != hipSuccess) { fprintf(stderr, "kernel_launch: hipFuncSetAttribute failed\n"); grid = -1; return; }
        int per_cu = 0;
        if (hipOccupancyMaxActiveBlocksPerMultiprocessor(&per_cu, (const void*)trunk_fwd, NWAVES * 64, LDS_BYTES) != hipSuccess || per_cu < 1) fprintf(stderr, "kernel_launch: occupancy query reports %d\n", per_cu);
        (void)hipGetLastError();
        grid = cus;
    }
    if (grid < 0) return;
    if (hipMemsetAsync((char*)d_ws + WS_CTL, 0, CTL_ZERO_BYTES, stream) != hipSuccess) return;
    Args a{};
    for (int i = 0; i < 19; ++i) a.in[i] = (const float*)d_in[i];
    a.out = (float*)d_out; a.ws = (unsigned char*)d_ws;
#if MK_ONE_LAUNCH
    a.l_lo = 0; a.l_hi = DEPTH; a.ph_lo = 0; a.ph_hi = NPHASE;
    hipLaunchKernelGGL(trunk_fwd, dim3(grid), dim3(NWAVES * 64), LDS_BYTES, stream, a);
#else
    for (int l = 0; l < DEPTH; ++l)
        for (int ph = 0; ph < NPHASE; ++ph) { a.l_lo = l; a.l_hi = l + 1; a.ph_lo = ph; a.ph_hi = ph + 1;
            hipLaunchKernelGGL(trunk_fwd, dim3(grid), dim3(NWAVES * 64), LDS_BYTES, stream, a); }
#endif
}
```

```cpp
#include <hip/hip_runtime.h>
#include <cstdio>
#include <cstdint>
#define GAS __attribute__((address_space(1)))

#ifndef MK_ONE_LAUNCH
#define MK_ONE_LAUNCH 1
#endif

namespace pg8 {
#define PG8_LAS __attribute__((address_space(3)))
typedef unsigned short bf16_t;
typedef short bf16x8 __attribute__((ext_vector_type(8)));
typedef float f32x4 __attribute__((ext_vector_type(4)));
typedef unsigned u32x4 __attribute__((ext_vector_type(4)));
constexpr int BM = 256, BK = 64, HALF = 128, HTB = HALF * BK * 2, STAGE_BYTES = 8 * HTB, NXCD = 8, WGM = 8;

__host__ __device__ __forceinline__ int lds_byte(int r, int c) { const int st = (r >> 4) * 2 + (c >> 5), rr = r & 15, cc = c & 31, ob = rr * 64 + cc * 2; return st * 1024 + (ob ^ (((ob >> 9) & 1) << 5)); }
__host__ __device__ __forceinline__ void stage_rc(int b, int& R, int& C) { const int st = b / 1024, sb = b % 1024, swz = sb ^ (((sb >> 9) & 1) << 5); R = (st >> 1) * 16 + swz / 64; C = (st & 1) * 32 + (swz % 64) / 2; }
__host__ __device__ __forceinline__ int perm32(int rho) { const int n = rho >> 4, i = rho & 15; return 8 * (i >> 2) + 4 * n + (i & 3); }

struct Unit { int pm, pn; };
struct Gemm { const GAS bf16_t* A; const GAS bf16_t* Bt; int M, N, K; };

struct StaticOrder {
    int nM, nN, nwg, G, c;
    __host__ __device__ void init(int M, int N, int G_, int c_) { nM = M / BM; nN = N / BM; nwg = nM * nN; G = G_; c = c_; }
    __host__ __device__ bool next(int i, Unit& u) const {
        const long L = (long)i * G + c; if (L >= nwg) return false;
        int wgid = (int)L; { const int q = nwg / NXCD, r = nwg % NXCD, xcd = wgid % NXCD, off = wgid / NXCD; wgid = (xcd < r ? xcd * (q + 1) : r * (q + 1) + (xcd - r) * q) + off; }
        const int nig = WGM * nN, gid = wgid / nig, fm = gid * WGM, gsz = (nM - fm) < WGM ? (nM - fm) : WGM;
        u.pm = fm + ((wgid % nig) % gsz); u.pn = (wgid % nig) / gsz; return true;
    }
    __device__ __forceinline__ void a_ready(const Unit&) const {}
    __device__ __forceinline__ void done(const Unit&) const {}
};

__device__ __forceinline__ unsigned cvt_pk_bf16(float lo, float hi) { unsigned r; asm volatile("v_cvt_pk_bf16_f32 %0, %1, %2" : "=v"(r) : "v"(lo), "v"(hi)); return r; }

struct EpiBf16 {
    static constexpr bool PERM = true, AFTER_DRAIN = false;
    GAS bf16_t* O; int ldc;
    __device__ __forceinline__ void operator()(const f32x4 (&acc)[2][2][4][2], const Unit& u, int wr, int wc, int fr, int fq) const {
        const int row0 = u.pm * BM + wr * 64 + fr; const int col0 = u.pn * BM + wc * 32 + 8 * fq;
#pragma unroll
        for (int ai = 0; ai < 2; ++ai)
#pragma unroll
            for (int m = 0; m < 4; ++m) { GAS bf16_t* rowp = O + (size_t)(row0 + ai * HALF + m * 16) * ldc + col0;
#pragma unroll
                for (int bj = 0; bj < 2; ++bj) { const f32x4 v0 = acc[ai][bj][m][0], v1 = acc[ai][bj][m][1];
                    u32x4 w; w.x = cvt_pk_bf16(v0[0], v0[1]); w.y = cvt_pk_bf16(v0[2], v0[3]); w.z = cvt_pk_bf16(v1[0], v1[1]); w.w = cvt_pk_bf16(v1[2], v1[3]);
                    *(GAS u32x4*)(rowp + bj * HALF) = w; } }
    }
};
struct EpiResF32 {
    static constexpr bool PERM = false, AFTER_DRAIN = false;
    const GAS float* base; GAS float* out; int ldc;
    __device__ __forceinline__ void operator()(const f32x4 (&acc)[2][2][4][2], const Unit& u, int wr, int wc, int fr, int fq) const {
        const int row0 = u.pm * BM + wr * 64 + fr, col0 = u.pn * BM + wc * 32 + 4 * fq;
#pragma unroll
        for (int ai = 0; ai < 2; ++ai)
#pragma unroll
            for (int m = 0; m < 4; ++m) { const size_t off = (size_t)(row0 + ai * HALF + m * 16) * ldc + col0;
#pragma unroll
                for (int bj = 0; bj < 2; ++bj)
#pragma unroll
                    for (int n = 0; n < 2; ++n) { const f32x4 b = *(const GAS f32x4*)(base + off + bj * HALF + n * 16); *(GAS f32x4*)(out + off + bj * HALF + n * 16) = b + acc[ai][bj][m][n]; } }
    }
};
__device__ __forceinline__ float silu_f(float x) { return x * __builtin_amdgcn_rcpf(1.0f + __expf(-x)); }
struct EpiSwiGLU {
    static constexpr bool PERM = true, AFTER_DRAIN = false;
    GAS bf16_t* O; int ldc;
    __device__ __forceinline__ void operator()(const f32x4 (&acc)[2][2][4][2], const Unit& u, int wr, int wc, int fr, int fq) const {
        const int row0 = u.pm * BM + wr * 64 + fr; const int col0 = u.pn * HALF + wc * 32 + 8 * fq;
#pragma unroll
        for (int ai = 0; ai < 2; ++ai)
#pragma unroll
            for (int m = 0; m < 4; ++m) { GAS bf16_t* rowp = O + (size_t)(row0 + ai * HALF + m * 16) * ldc + col0;
                const f32x4 g0 = acc[ai][0][m][0], g1 = acc[ai][0][m][1], u0 = acc[ai][1][m][0], u1 = acc[ai][1][m][1];
                float r[8];
#pragma unroll
                for (int j = 0; j < 4; ++j) { r[j] = silu_f(g0[j]) * u0[j]; r[4 + j] = silu_f(g1[j]) * u1[j]; }
                u32x4 w; w.x = cvt_pk_bf16(r[0], r[1]); w.y = cvt_pk_bf16(r[2], r[3]); w.z = cvt_pk_bf16(r[4], r[5]); w.w = cvt_pk_bf16(r[6], r[7]);
                *(GAS u32x4*)rowp = w; }
    }
};

template <class Epi, class Sched, bool ALIGN_EPI = false, bool SP2 = false>
__device__ __forceinline__ void gemm_phase(PG8_LAS unsigned char* lds, const Gemm g, const Sched& S, const Epi& E, int wave_id) {
    int tid_; asm volatile("v_mbcnt_lo_u32_b32 %0, -1, 0\n\tv_mbcnt_hi_u32_b32 %0, -1, %0" : "=v"(tid_)); tid_ += wave_id * 64;
    const int tid = tid_, wid = __builtin_amdgcn_readfirstlane(tid >> 6), lane = tid & 63, wr = wid >> 2, wc = wid & 3, fr = lane & 15, fq = lane >> 4;
    const int K = g.K, nt = K / BK;
    unsigned voffA[2], voffB[2];
#pragma unroll
    for (int i = 0; i < 2; ++i) { int R, C; stage_rc(tid * 16 + i * 8192, R, C); const int Rb = Epi::PERM ? ((R & ~31) + perm32(R & 31)) : R;
        voffA[i] = (unsigned)(R * K + C) * 2u; voffB[i] = (unsigned)(Rb * K + C) * 2u; }
    const size_t kstep = (size_t)(BK * 2);
    const size_t hstep = (size_t)HALF * K * 2;
    const size_t tstep = 2 * hstep;
    const unsigned ldsw = (unsigned)wid * 1024u;
    const int aoff = lds_byte(wr * 64 + fr, fq * 8), boff = lds_byte(wc * 32 + fr, fq * 8);
#define PG8_SA(b, h) (((b) * 2 + (h)) * HTB)
#define PG8_SB(b, h) ((4 + (b) * 2 + (h)) * HTB)
#define PG8_STAGE(bufoff, gbase, voff) do { _Pragma("unroll") for (int _i = 0; _i < 2; ++_i) \
        __builtin_amdgcn_global_load_lds((const GAS unsigned*)((const GAS char*)(gbase) + (voff)[_i]), (PG8_LAS unsigned*)(lds + (bufoff) + ldsw + _i * 8192), 16, 0, 0); } while (0)
#define PG8_LDA(dst, b, h) do { _Pragma("unroll") for (int m = 0; m < 4; ++m) _Pragma("unroll") for (int k = 0; k < 2; ++k) dst[m][k] = *(const PG8_LAS bf16x8*)(lds + PG8_SA(b, h) + aoff + m * 2048 + k * 1024); } while (0)
#define PG8_LDB(dst, b, h) do { _Pragma("unroll") for (int n = 0; n < 2; ++n) _Pragma("unroll") for (int k = 0; k < 2; ++k) dst[n][k] = *(const PG8_LAS bf16x8*)(lds + PG8_SB(b, h) + boff + n * 2048 + k * 1024); } while (0)
#define PG8_MMA(ai, bj, At, Bt) do { __builtin_amdgcn_s_setprio(1); _Pragma("unroll") for (int m = 0; m < 4; ++m) _Pragma("unroll") for (int n = 0; n < 2; ++n) _Pragma("unroll") for (int k = 0; k < 2; ++k) \
        acc[ai][bj][m][n] = __builtin_amdgcn_mfma_f32_16x16x32_bf16(Bt[n][k], At[m][k], acc[ai][bj][m][n], 0, 0, 0); __builtin_amdgcn_s_setprio(0); } while (0)
#define PG8_WAIT_V(n) asm volatile("s_waitcnt vmcnt(" #n ")" ::: "memory")
#define PG8_WAIT_L(n) asm volatile("s_waitcnt lgkmcnt(" #n ")" ::: "memory")
#define PG8_BAR __builtin_amdgcn_s_barrier()
#define PG8_SCHED __builtin_amdgcn_sched_barrier(0)
    Unit cur, nxt; int ui = 0;
    if (!S.next(0, cur)) return;
    f32x4 acc[2][2][4][2];
#pragma unroll
    for (int a = 0; a < 2; ++a)
#pragma unroll
        for (int b = 0; b < 2; ++b)
#pragma unroll
            for (int m = 0; m < 4; ++m)
#pragma unroll
                for (int n = 0; n < 2; ++n) acc[a][b][m][n] = (f32x4){0.f, 0.f, 0.f, 0.f};
    bf16x8 At[4][2], B0[2][2], B1[2][2];
    const GAS char* cA = (const GAS char*)g.A + (size_t)cur.pm * tstep; const GAS char* cB = (const GAS char*)g.Bt + (size_t)cur.pn * tstep;
    S.a_ready(cur);
    if constexpr (SP2) {
        PG8_STAGE(PG8_SB(0, 0), cB, voffB); PG8_STAGE(PG8_SB(0, 1), cB + hstep, voffB); PG8_STAGE(PG8_SA(0, 0), cA, voffA); PG8_STAGE(PG8_SA(0, 1), cA + hstep, voffA);
        if (wr == 1) PG8_BAR;
        PG8_WAIT_V(2); PG8_BAR;
        PG8_STAGE(PG8_SB(1, 0), cB + kstep, voffB); PG8_STAGE(PG8_SA(1, 0), cA + kstep, voffA); PG8_STAGE(PG8_SB(1, 1), cB + hstep + kstep, voffB);
        PG8_WAIT_V(6); PG8_BAR;
    } else {
        PG8_STAGE(PG8_SB(0, 0), cB, voffB); PG8_STAGE(PG8_SA(0, 0), cA, voffA); PG8_STAGE(PG8_SB(0, 1), cB + hstep, voffB); PG8_STAGE(PG8_SA(0, 1), cA + hstep, voffA);
        if (wr == 1) PG8_BAR;
        PG8_WAIT_V(4); PG8_BAR;
        PG8_STAGE(PG8_SB(1, 0), cB + kstep, voffB); PG8_STAGE(PG8_SA(1, 0), cA + kstep, voffA); PG8_STAGE(PG8_SB(1, 1), cB + hstep + kstep, voffB);
        PG8_WAIT_V(6); PG8_BAR;
    }
    for (;;) {
        const bool has_next = S.next(ui + 1, nxt);
        const GAS char* nA = has_next ? (const GAS char*)g.A + (size_t)nxt.pm * tstep : cA; const GAS char* nB = has_next ? (const GAS char*)g.Bt + (size_t)nxt.pn * tstep : cB;
        for (int t = 0; t < nt; t += 2) {
            const bool last = (t == nt - 2);
            const GAS char* a1 = cA + (size_t)(t + 1) * kstep;
            const GAS char* a2 = last ? nA : cA + (size_t)(t + 2) * kstep; const GAS char* b2 = last ? nB : cB + (size_t)(t + 2) * kstep;
            const GAS char* a3 = a2 + kstep; const GAS char* b3 = b2 + kstep;
            if (last && has_next) S.a_ready(nxt);
            if constexpr (SP2) {
            PG8_LDB(B0, 0, 0); PG8_LDB(B1, 0, 1); PG8_SCHED; PG8_LDA(At, 0, 0); PG8_STAGE(PG8_SA(1, 1), a1 + hstep, voffA);
            PG8_WAIT_V(8); PG8_WAIT_L(0); PG8_BAR; PG8_MMA(0, 0, At, B0); PG8_MMA(0, 1, At, B1); PG8_BAR; PG8_SCHED;
            PG8_LDA(At, 0, 1); PG8_STAGE(PG8_SB(0, 0), b2, voffB); PG8_STAGE(PG8_SB(0, 1), b2 + hstep, voffB); PG8_STAGE(PG8_SA(0, 0), a2, voffA);
            PG8_WAIT_V(8); PG8_WAIT_L(0); PG8_BAR; PG8_MMA(1, 0, At, B0); PG8_MMA(1, 1, At, B1); PG8_BAR; PG8_SCHED;
            PG8_LDB(B0, 1, 0); PG8_LDB(B1, 1, 1); PG8_SCHED; PG8_LDA(At, 1, 0); PG8_STAGE(PG8_SA(0, 1), a2 + hstep, voffA);
            PG8_WAIT_V(8); PG8_WAIT_L(0); PG8_BAR; PG8_MMA(0, 0, At, B0); PG8_MMA(0, 1, At, B1); PG8_BAR; PG8_SCHED;
            PG8_LDA(At, 1, 1); PG8_STAGE(PG8_SB(1, 0), b3, voffB); PG8_STAGE(PG8_SB(1, 1), b3 + hstep, voffB); PG8_STAGE(PG8_SA(1, 0), a3, voffA);
            PG8_WAIT_V(8); PG8_WAIT_L(0); PG8_BAR; PG8_MMA(1, 0, At, B0); PG8_MMA(1, 1, At, B1); PG8_BAR; PG8_SCHED;
            } else {
            PG8_LDB(B0, 0, 0); PG8_SCHED; PG8_LDA(At, 0, 0); PG8_STAGE(PG8_SA(1, 1), a1 + hstep, voffA);
            PG8_WAIT_L(8); PG8_BAR; PG8_WAIT_L(0); PG8_MMA(0, 0, At, B0); PG8_BAR; PG8_SCHED;
            PG8_LDB(B1, 0, 1); PG8_STAGE(PG8_SB(0, 0), b2, voffB);
            PG8_BAR; PG8_WAIT_L(0); PG8_MMA(0, 1, At, B1); PG8_BAR;
            PG8_LDA(At, 0, 1); PG8_STAGE(PG8_SA(0, 0), a2, voffA);
            PG8_BAR; PG8_WAIT_L(0); PG8_MMA(1, 0, At, B0); PG8_BAR; PG8_SCHED;
            PG8_STAGE(PG8_SB(0, 1), b2 + hstep, voffB);
            PG8_WAIT_V(6); PG8_BAR; PG8_MMA(1, 1, At, B1); PG8_BAR;
            PG8_LDB(B0, 1, 0); PG8_SCHED; PG8_LDA(At, 1, 0); PG8_STAGE(PG8_SA(0, 1), a2 + hstep, voffA);
            PG8_WAIT_L(8); PG8_BAR; PG8_WAIT_L(0); PG8_MMA(0, 0, At, B0); PG8_BAR; PG8_SCHED;
            PG8_LDB(B1, 1, 1); PG8_STAGE(PG8_SB(1, 0), b3, voffB);
            PG8_BAR; PG8_WAIT_L(0); PG8_MMA(0, 1, At, B1); PG8_BAR;
            PG8_LDA(At, 1, 1); PG8_STAGE(PG8_SA(1, 0), a3, voffA);
            PG8_BAR; PG8_WAIT_L(0); PG8_MMA(1, 0, At, B0); PG8_BAR; PG8_SCHED;
            PG8_STAGE(PG8_SB(1, 1), b3 + hstep, voffB);
            PG8_WAIT_V(6); PG8_BAR; PG8_MMA(1, 1, At, B1); PG8_BAR;
            }
        }
        if constexpr (ALIGN_EPI) { if (wr == 0) PG8_BAR; }
        if constexpr (!Epi::AFTER_DRAIN) { E(acc, cur, wr, wc, fr, fq); S.done(cur); }
        if (!has_next) break;
#pragma unroll
        for (int a = 0; a < 2; ++a)
#pragma unroll
            for (int b = 0; b < 2; ++b)
#pragma unroll
                for (int m = 0; m < 4; ++m)
#pragma unroll
                    for (int n = 0; n < 2; ++n) acc[a][b][m][n] = (f32x4){0.f, 0.f, 0.f, 0.f};
        cur = nxt; cA = nA; cB = nB; ++ui;
        if constexpr (ALIGN_EPI) { if (wr == 1) PG8_BAR; }
    }
    PG8_WAIT_V(0);
    if constexpr (!ALIGN_EPI) { if (wr == 0) PG8_BAR; }
    PG8_BAR;
#undef PG8_SA
#undef PG8_SB
#undef PG8_STAGE
#undef PG8_LDA
#undef PG8_LDB
#undef PG8_MMA
#undef PG8_WAIT_V
#undef PG8_WAIT_L
#undef PG8_BAR
#undef PG8_SCHED
}
}

constexpr int NWAVES = 8;
constexpr int DM = 2048, NBATCH = 16, SEQ = 2048, MTOK = NBATCH * SEQ, DEPTH = 4;
constexpr int NPROJ = 7168, PROJ_ORIG = 6942, DFF = 5632, NGU = 2 * DFF;
constexpr int GH = 6, HD = 128, NHKV = 2, NCMP = 127;
constexpr int PC_GQKV = 0, PC_GZ = 2304, PC_NQ = 3072, PC_NKV = 3840, PC_CU = 5376, PC_CB = 5888, PC_CC = 6400, PC_GB = 6912, PC_GA = 6918, PC_NG = 6924;
constexpr float RMS_EPS = 1e-6f;
constexpr int NPHASE = 10;

constexpr size_t MiB = 1u << 20;
constexpr size_t WS_CTL = 0, CTL_ZERO_BYTES = 1 * MiB;
constexpr size_t WS_WIN = 2 * MiB, WS_WOUT = 30 * MiB, WS_WGU = 38 * MiB, WS_WDN = 82 * MiB;
constexpr size_t WS_H = 104 * MiB;
constexpr size_t WS_PROJ = 232 * MiB;
constexpr size_t WS_GQ = 680 * MiB, WS_GK = 728 * MiB, WS_GV = 776 * MiB;
constexpr size_t WS_GO = 824 * MiB;
constexpr size_t WS_GU = 872 * MiB;
constexpr size_t WS_ATT = 994 * MiB;
constexpr size_t WS_EGL = 1018 * MiB;
constexpr size_t WS_KN = 920 * MiB;
constexpr size_t WS_KCB = 952 * MiB;
constexpr size_t WS_VCT = 953 * MiB;
constexpr size_t WS_GBG = 956 * MiB;
constexpr size_t WS_VT = 958 * MiB;
constexpr size_t WS_W1T = 990 * MiB;
constexpr size_t WS_W2T = 992 * MiB;
constexpr size_t WS_CBP = 992 * MiB + 131072;
constexpr size_t WS_SEL = 993 * MiB;
constexpr size_t WS_END = 1019 * MiB;
constexpr int CW_TMO = 0, CW_BAR = 4096, CW_Q = 16384;

constexpr int RING_OFF = 0, RING_BYTES = 131072;
constexpr int LDSCTL_OFF = RING_BYTES, MISC_OFF = LDSCTL_OFF + 320, BTAB_OFF = LDSCTL_OFF + 1024, FL_OFF = LDSCTL_OFF + 8192;
constexpr int LDS_BYTES = 147456;

#define LAS __attribute__((address_space(3)))
typedef unsigned short bf16;
typedef unsigned v4u __attribute__((ext_vector_type(4)));
typedef unsigned v2u __attribute__((ext_vector_type(2)));
typedef float f32x4 __attribute__((ext_vector_type(4)));
typedef GAS unsigned gu32;
#define RLX_AGENT __ATOMIC_RELAXED, __HIP_MEMORY_SCOPE_AGENT
#define LDS_WAIT() asm volatile("s_waitcnt lgkmcnt(0)" ::: "memory")
__device__ __forceinline__ unsigned f2bf(float f) { unsigned u = __builtin_bit_cast(unsigned, f); return (u + 0x7fffu + ((u >> 16) & 1u)) >> 16; }
__device__ __forceinline__ unsigned pk2(float lo, float hi) { return f2bf(lo) | (f2bf(hi) << 16); }
__device__ __forceinline__ float bflo(unsigned w) { return __uint_as_float(w << 16); }
__device__ __forceinline__ float bfhi(unsigned w) { return __uint_as_float(w & 0xffff0000u); }
__device__ __forceinline__ float bf2f(bf16 b) { return __uint_as_float(((unsigned)b) << 16); }
__device__ __forceinline__ float xl1(float v) { return __int_as_float(__builtin_amdgcn_update_dpp(0, __float_as_int(v), 0xB1, 0xf, 0xf, false)); }
__device__ __forceinline__ float xl2(float v) { return __int_as_float(__builtin_amdgcn_update_dpp(0, __float_as_int(v), 0x4E, 0xf, 0xf, false)); }
__device__ __forceinline__ float xl7(float v) { return __int_as_float(__builtin_amdgcn_update_dpp(0, __float_as_int(v), 0x141, 0xf, 0xf, false)); }
__device__ __forceinline__ float xl15(float v) { return __int_as_float(__builtin_amdgcn_update_dpp(0, __float_as_int(v), 0x140, 0xf, 0xf, false)); }
__device__ __forceinline__ float xl16(float v) { return __int_as_float(__builtin_amdgcn_ds_swizzle(__float_as_int(v), 0x401F)); }
__device__ __forceinline__ float sum32(float v) { auto r = __builtin_amdgcn_permlane32_swap(__float_as_uint(v), __float_as_uint(v), false, false); return __uint_as_float(r[0]) + __uint_as_float(r[1]); }
__device__ __forceinline__ float max32(float v) { auto r = __builtin_amdgcn_permlane32_swap(__float_as_uint(v), __float_as_uint(v), false, false); return fmaxf(__uint_as_float(r[0]), __uint_as_float(r[1])); }
__device__ __forceinline__ unsigned or32(unsigned v) { auto r = __builtin_amdgcn_permlane32_swap(v, v, false, false); return r[0] | r[1]; }
__device__ __forceinline__ float wave_sum(float v) { v += xl1(v); v += xl2(v); v += xl7(v); v += xl15(v); v += xl16(v); return sum32(v); }
__device__ __forceinline__ float wave_max(float v) { v = fmaxf(v, xl1(v)); v = fmaxf(v, xl2(v)); v = fmaxf(v, xl7(v)); v = fmaxf(v, xl15(v)); v = fmaxf(v, xl16(v)); return max32(v); }
__device__ __forceinline__ unsigned wave_or(unsigned v) { v |= __float_as_uint(xl1(__uint_as_float(v))); v |= __float_as_uint(xl2(__uint_as_float(v))); v |= __float_as_uint(xl7(__uint_as_float(v))); v |= __float_as_uint(xl15(__uint_as_float(v))); v |= __float_as_uint(xl16(__uint_as_float(v))); return or32(v); }
__device__ __forceinline__ int lane_id() { return (int)__builtin_amdgcn_mbcnt_hi(~0u, __builtin_amdgcn_mbcnt_lo(~0u, 0u)); }
__device__ __forceinline__ float sigmoid_f(float x) { return 1.0f / (1.0f + __expf(-x)); }
__device__ __forceinline__ float rl(float v, int l) { return __int_as_float(__builtin_amdgcn_readlane(__float_as_int(v), l)); }

__constant__ unsigned char T5B[128] = {0, 1, 2, 3, 4, 5, 6, 7, 8, 9, 10, 11, 12, 13, 14, 15, 16, 16, 16, 17, 17, 18, 18, 18, 19, 19, 19, 20, 20, 20, 20, 21, 21, 21, 21, 22, 22, 22, 22, 22, 23, 23, 23, 23, 23, 23, 24, 24, 24, 24, 24, 24, 25, 25, 25, 25, 25, 25, 25, 26, 26, 26, 26, 26, 26, 26, 26, 27, 27, 27, 27, 27, 27, 27, 27, 27, 27, 28, 28, 28, 28, 28, 28, 28, 28, 28, 28, 29, 29, 29, 29, 29, 29, 29, 29, 29, 29, 29, 29, 30, 30, 30, 30, 30, 30, 30, 30, 30, 30, 30, 30, 30, 30, 31, 31, 31, 31, 31, 31, 31, 31, 31, 31, 31, 31, 31, 31, 31};

#define XB_TMO      128
#define XB_XCNT(j)  (256  + 64 * (j))
#define XB_XSUB(j)  (1280 + 64 * (j))
#define XB_XGEN(j)  (2304 + 64 * (j))
#define XB_TOP      3328
#define XB_TOPGEN   3392
#define XCD_BAR_WORDS 3456
#define XB_SPIN_CAP (1u << 22)
__device__ __forceinline__ unsigned xb_ld(GAS unsigned* p)              { return __hip_atomic_load(p, __ATOMIC_RELAXED, __HIP_MEMORY_SCOPE_AGENT); }
__device__ __forceinline__ unsigned xb_add(GAS unsigned* p, unsigned v) { return __hip_atomic_fetch_add(p, v, __ATOMIC_RELAXED, __HIP_MEMORY_SCOPE_AGENT); }
__device__ __forceinline__ unsigned xb_xcc_id() { return (unsigned)__builtin_amdgcn_s_getreg((3 << 11) | 20) & 0xFu; }
#define XB_SPIN(cond, bar) do { unsigned _sp = 0; while (cond) { __builtin_amdgcn_s_sleep(1); \
    if ((++_sp & 255u) == 0u) { if (xb_ld(&(bar)[XB_TMO])) break; if (_sp > XB_SPIN_CAP) { (void)xb_add(&(bar)[XB_TMO], 1u); break; } } } } while (0)
struct XcdBarrier { GAS unsigned* bar; unsigned x; volatile LAS unsigned* st; };
__device__ __forceinline__ XcdBarrier xcd_barrier_post(GAS unsigned* bar, volatile LAS unsigned* st) {
    XcdBarrier b; b.bar = bar; b.x = xb_xcc_id(); b.st = st;
    if (threadIdx.x == 0) (void)xb_add(&bar[XB_XCNT(b.x)], 1u);
    return b;
}
__device__ __forceinline__ void xcd_barrier_complete(GAS unsigned* bar, unsigned x, unsigned& nloc, unsigned& nx) {
    const unsigned G = gridDim.x * gridDim.y * gridDim.z;
    unsigned sum, cnt, mine, sp = 0u;
    for (;;) {
        sum = 0u; cnt = 0u; mine = 0u;
#pragma unroll
        for (unsigned j = 0; j < 16; ++j) { const unsigned c = xb_ld(&bar[XB_XCNT(j)]); sum += c; cnt += (c > 0u) ? 1u : 0u; mine = (j == x) ? c : mine; }
        if (sum == G) break;
        __builtin_amdgcn_s_sleep(1);
        if ((++sp & 255u) == 0u) { if (xb_ld(&bar[XB_TMO])) break; if (sp > XB_SPIN_CAP) { (void)xb_add(&bar[XB_TMO], 1u); break; } }
    }
    nloc = mine > 0u ? mine : 1u; nx = cnt > 0u ? cnt : 1u;
}
__device__ __forceinline__ void xcd_barrier(const XcdBarrier& b, int tid) {
    asm volatile("s_waitcnt vmcnt(0)" ::: "memory");
    __syncthreads();
    if (tid == 0) {
        GAS unsigned* bar = b.bar;
        __builtin_amdgcn_s_waitcnt(0);
        unsigned nloc = b.st[0], nx = b.st[1];
        if (nloc == 0u) { xcd_barrier_complete(bar, b.x, nloc, nx); b.st[0] = nloc; b.st[1] = nx; }
        const unsigned old = xb_add(&bar[XB_XSUB(b.x)], 1u);
        const unsigned gen = old / nloc;
        if (old + 1u == (gen + 1u) * nloc) {
            __builtin_amdgcn_fence(__ATOMIC_RELEASE, "agent");
            asm volatile("s_waitcnt vmcnt(0)" ::: "memory");
            const unsigned og = xb_add(&bar[XB_TOP], 1u);
            const unsigned tg = og / nx;
            if (og + 1u == (tg + 1u) * nx) xb_add(&bar[XB_TOPGEN], 1u);
            else XB_SPIN(xb_ld(&bar[XB_TOPGEN]) == tg, bar);
            __builtin_amdgcn_fence(__ATOMIC_ACQUIRE, "agent");
            xb_add(&bar[XB_XGEN(b.x)], 1u);
            asm volatile("s_waitcnt vmcnt(0)" ::: "memory");
        } else {
            XB_SPIN(xb_ld(&bar[XB_XGEN(b.x)]) == gen, bar);
            __builtin_amdgcn_fence(__ATOMIC_ACQUIRE, "agent");
            asm volatile("s_waitcnt vmcnt(0)" ::: "memory");
        }
    }
    __syncthreads();
}

struct Frame {
    LAS unsigned char* lds;
    gu32* ctl;
    int wave, vcu, G;
    __device__ __forceinline__ int lane() const { int l; asm volatile("v_mbcnt_lo_u32_b32 %0, -1, 0\n\tv_mbcnt_hi_u32_b32 %0, -1, %0" : "=v"(l)); return l; }
    __device__ __forceinline__ int tid() const { return wave * 64 + lane(); }
    const __attribute__((address_space(4))) unsigned char* kp;
    GAS float* out; GAS unsigned char* ws_;
    __device__ __forceinline__ GAS unsigned char* wsb() const { GAS unsigned char* p = ws_; asm volatile("" : "+s"(p)); return p; }
    __device__ __forceinline__ const GAS float* inp(int i) const { const __attribute__((address_space(4))) unsigned char* p = kp; asm volatile("" : "+s"(p)); return ((const GAS float* const __attribute__((address_space(4)))*)p)[i]; }
};
enum { I_X = 0, I_RELB, I_NMIX, I_WIN, I_GCONV, I_GALOG, I_GDT, I_GNORM, I_NQN, I_NKN, I_CPOS, I_CW1, I_CW2, I_SCW, I_WOUT, I_NFFN, I_WG, I_WU, I_WD };

__device__ __forceinline__ void transpose_tile(const GAS float* W, int ldw, int scol, GAS bf16* WTrow0, int K, int k0, LAS float* scr, int lane) {
    float tv[32];
#pragma unroll
    for (int i = 0; i < 32; ++i) { const int kk = 2 * i + (lane >> 5); tv[i] = scol >= 0 ? W[(size_t)(k0 + kk) * ldw + scol] : 0.f; }
#pragma unroll
    for (int i = 0; i < 32; ++i) { const int kk = 2 * i + (lane >> 5); scr[kk * 33 + (lane & 31)] = tv[i]; }
    LDS_WAIT();
    const int c = lane & 7;
#pragma unroll
    for (int j = 0; j < 4; ++j) { const int n = (lane >> 3) + 8 * j; const LAS float* s = scr + (8 * c) * 33 + n;
        v4u o; o.x = pk2(s[0 * 33], s[1 * 33]); o.y = pk2(s[2 * 33], s[3 * 33]); o.z = pk2(s[4 * 33], s[5 * 33]); o.w = pk2(s[6 * 33], s[7 * 33]);
        *(GAS v4u*)(WTrow0 + (size_t)n * K + k0 + 8 * c) = o; }
    LDS_WAIT();
}
__device__ __forceinline__ int win_src(int n) {
    if (n < 3072) return n;
    if (n < 5376) return n + 12;
    if (n < 6912) return n + 30;
    if (n < 6924) return n - 6912 + 3072;
    if (n < 6942) return n - 6924 + 5388;
    return -1;
}
__device__ __forceinline__ void tt_load(const GAS float* W, int ldw, int scol, int k0, float (&tv)[32], int lane) {
#pragma unroll
    for (int i = 0; i < 32; ++i) { const int kk = 2 * i + (lane >> 5); tv[i] = scol >= 0 ? W[(size_t)(k0 + kk) * ldw + scol] : 0.f; }
}
__device__ __forceinline__ void tt_store(const float (&tv)[32], GAS bf16* WTrow0, int K, int k0, LAS float* scr, int lane) {
#pragma unroll
    for (int i = 0; i < 32; ++i) { const int kk = 2 * i + (lane >> 5); scr[kk * 33 + (lane & 31)] = tv[i]; }
    LDS_WAIT();
    const int c = lane & 7;
#pragma unroll
    for (int j = 0; j < 4; ++j) { const int n = (lane >> 3) + 8 * j; const LAS float* s = scr + (8 * c) * 33 + n;
        v4u o; o.x = pk2(s[0 * 33], s[1 * 33]); o.y = pk2(s[2 * 33], s[3 * 33]); o.z = pk2(s[4 * 33], s[5 * 33]); o.w = pk2(s[6 * 33], s[7 * 33]);
        *(GAS v4u*)(WTrow0 + (size_t)n * K + k0 + 8 * c) = o; }
    LDS_WAIT();
}
__device__ __forceinline__ void conv_decode(Frame& F, int l, int it, int lane, const GAS float*& W, int& ldw, int& scol, GAS bf16*& WT, int& K, int& k0) {
    constexpr int I_A = 32 * (NPROJ / 32), I_B = 32 * (DM / 32), I_C = 32 * (NGU / 32);
    int r = it;
    if (r < I_A) { const int nblk = NPROJ / 32, kb = r / nblk, nb = r % nblk;
        W = F.inp(I_WIN) + (size_t)l * DM * PROJ_ORIG; ldw = PROJ_ORIG; scol = win_src(nb * 32 + (lane & 31)); WT = (GAS bf16*)(F.wsb() + WS_WIN) + (size_t)(nb * 32) * DM; K = DM; k0 = kb * 64; return; }
    r -= I_A;
    if (r < I_B) { const int nblk = DM / 32, kb = r / nblk, nb = r % nblk;
        W = F.inp(I_WOUT) + (size_t)l * DM * DM; ldw = DM; scol = nb * 32 + (lane & 31); WT = (GAS bf16*)(F.wsb() + WS_WOUT) + (size_t)(nb * 32) * DM; K = DM; k0 = kb * 64; return; }
    r -= I_B;
    if (r < I_C) { const int nblk = NGU / 32, kb = r / nblk, nb = r % nblk; const int n0 = nb * 32, pn = n0 >> 8, rr = n0 & 255;
        const GAS float* src = (rr < 128) ? F.inp(I_WG) : F.inp(I_WU);
        W = src + (size_t)l * DM * DFF; ldw = DFF; scol = pn * 128 + (rr & 127) + (lane & 31); WT = (GAS bf16*)(F.wsb() + WS_WGU) + (size_t)n0 * DM; K = DM; k0 = kb * 64; return; }
    r -= I_C;
    { const int nblk = DM / 32, kb = r / nblk, nb = r % nblk;
        W = F.inp(I_WD) + (size_t)l * DFF * DM; ldw = DM; scol = nb * 32 + (lane & 31); WT = (GAS bf16*)(F.wsb() + WS_WDN) + (size_t)(nb * 32) * DFF; K = DFF; k0 = kb * 64; }
}
__device__ __forceinline__ void ph_convert(Frame& F, int l) {
    LAS float* scr = (LAS float*)(F.lds + RING_OFF + F.wave * 16384);
    const int gw = F.vcu * NWAVES + F.wave, NGW = F.G * NWAVES, lane = F.lane();
    constexpr int I_A = 32 * (NPROJ / 32), I_B = 32 * (DM / 32), I_C = 32 * (NGU / 32), I_D = (DFF / 64) * (DM / 32);
    GAS bf16* WIN = (GAS bf16*)(F.wsb() + WS_WIN); GAS bf16* WOUT = (GAS bf16*)(F.wsb() + WS_WOUT); GAS bf16* WGU = (GAS bf16*)(F.wsb() + WS_WGU); GAS bf16* WDN = (GAS bf16*)(F.wsb() + WS_WDN);
    constexpr int NIT = I_A + I_B + I_C + I_D;
    for (int it = gw; it < NIT; it += 2 * NGW) {
        const int it2 = it + NGW; const bool two = it2 < NIT;
        const GAS float* W0; int ldw0, sc0, K0, k00; GAS bf16* T0; const GAS float* W1; int ldw1, sc1, K1, k01; GAS bf16* T1;
        conv_decode(F, l, it, lane, W0, ldw0, sc0, T0, K0, k00);
        conv_decode(F, l, two ? it2 : it, lane, W1, ldw1, sc1, T1, K1, k01);
        float ta[32], tb[32];
        tt_load(W0, ldw0, sc0, k00, ta, lane);
        if (two) tt_load(W1, ldw1, sc1, k01, tb, lane);
        tt_store(ta, T0, K0, k00, scr, lane);
        if (two) tt_store(tb, T1, K1, k01, scr, lane);
    }
    GAS bf16* W1T = (GAS bf16*)(F.wsb() + WS_W1T); GAS bf16* W2T = (GAS bf16*)(F.wsb() + WS_W2T); GAS float* CBP = (GAS float*)(F.wsb() + WS_CBP);
    for (int it = gw; it < 512 + 16 + 32; it += NGW) {
        int r = it;
        if (r < 512) { const int sel = r >> 8, q = r & 255, kb = q >> 2, nb = q & 3;
            transpose_tile(F.inp(I_CW1) + (size_t)(l * 2 + sel) * 4096 * HD, HD, nb * 32 + (lane & 31), W1T + (size_t)(sel * HD + nb * 32) * 4096, 4096, kb * 64, scr, lane); continue; }
        r -= 512;
        if (r < 16) { const int sel = r >> 3, q = r & 7, kb = q >> 2, nb = q & 3;
            transpose_tile(F.inp(I_CW2) + (size_t)(l * 2 + sel) * HD * HD, HD, nb * 32 + (lane & 31), W2T + (size_t)(sel * HD + nb * 32) * HD, HD, kb * 64, scr, lane); continue; }
        r -= 16;
        { const int sel = r >> 4, ch = r & 15; const GAS float* pe = F.inp(I_CPOS) + (size_t)(l * 2 + sel) * 4096 + ch * 256; const GAS float* w1 = F.inp(I_CW1) + ((size_t)(l * 2 + sel) * 4096 + ch * 256) * HD;
            float h0 = 0.f, h1 = 0.f;
            for (int i = 0; i < 256; ++i) { const float a = pe[i]; h0 += a * w1[(size_t)i * HD + lane]; h1 += a * w1[(size_t)i * HD + 64 + lane]; }
            CBP[(sel * 16 + ch) * HD + lane] = h0; CBP[(sel * 16 + ch) * HD + 64 + lane] = h1; }
    }
}
__device__ __forceinline__ void ph_norm(Frame& F, const GAS float* x, const GAS float* gain) {
    const int gw = F.vcu * NWAVES + F.wave, NGW = F.G * NWAVES, lane = F.lane(); GAS bf16* H = (GAS bf16*)(F.wsb() + WS_H);
    const GAS f32x4* gr = (const GAS f32x4*)gain + lane;
    for (int m = 4 * gw; m < MTOK; m += 4 * NGW) {
        f32x4 v[4][8]; float sq[4];
#pragma unroll
        for (int q = 0; q < 4; ++q)
#pragma unroll
            for (int j = 0; j < 8; ++j) v[q][j] = ((const GAS f32x4*)(x + (size_t)(m + q) * DM) + lane)[64 * j];
#pragma unroll
        for (int q = 0; q < 4; ++q) { float a = 0.f;
#pragma unroll
            for (int j = 0; j < 8; ++j) a += (v[q][j].x * v[q][j].x + v[q][j].y * v[q][j].y) + (v[q][j].z * v[q][j].z + v[q][j].w * v[q][j].w);
            sq[q] = 1.0f / sqrtf(wave_sum(a) * (1.f / DM) + RMS_EPS); }
#pragma unroll
        for (int j = 0; j < 8; ++j) { const f32x4 g = gr[64 * j];
#pragma unroll
            for (int q = 0; q < 4; ++q) { v2u w; w.x = pk2(v[q][j].x * sq[q] * g.x, v[q][j].y * sq[q] * g.y); w.y = pk2(v[q][j].z * sq[q] * g.z, v[q][j].w * sq[q] * g.w);
                ((GAS v2u*)(H + (size_t)(m + q) * DM) + lane)[64 * j] = w; } }
    }
}

typedef short bf16x8 __attribute__((ext_vector_type(8)));
typedef short s16x4 __attribute__((ext_vector_type(4)));
typedef float f32x16 __attribute__((ext_vector_type(16)));
__device__ __forceinline__ int crow(int r, int hi) { return (r & 3) + 8 * (r >> 2) + 4 * hi; }
__device__ __forceinline__ bf16x8 ld16(const GAS bf16* p) { return *(const GAS bf16x8*)p; }
__device__ __forceinline__ bf16x8 ld8x2(const GAS bf16* p) { const s16x4 a = *(const GAS s16x4*)p, b = *(const GAS s16x4*)(p + 8); return (bf16x8){a[0], a[1], a[2], a[3], b[0], b[1], b[2], b[3]}; }
__device__ __forceinline__ bf16x8 pack8f(float a0, float a1, float a2, float a3, float a4, float a5, float a6, float a7) {
    v4u w; w.x = pg8::cvt_pk_bf16(a0, a1); w.y = pg8::cvt_pk_bf16(a2, a3); w.z = pg8::cvt_pk_bf16(a4, a5); w.w = pg8::cvt_pk_bf16(a6, a7); return __builtin_bit_cast(bf16x8, w); }
#define MFMA32(a, b, c) __builtin_amdgcn_mfma_f32_32x32x16_bf16((a), (b), (c), 0, 0, 0)
constexpr float LOG2E = 1.4426950408889634f;

__device__ __forceinline__ void cmp_unit(Frame& F, int l, int it) {
    const int lane = F.lane(), r32 = lane & 31, hi = lane >> 5;
    const int nb = it & 3, r1 = it >> 2, hkv = r1 & 1, r2 = r1 >> 1, b = r2 % NBATCH, sel = r2 / NBATCH;
    const int n = 32 * nb + r32;
    const GAS bf16* P = (const GAS bf16*)(F.wsb() + WS_PROJ);
    const GAS bf16* brow = P + ((size_t)b * SEQ + 16 * n) * NPROJ + PC_NKV + sel * 256 + hkv * 128 + 8 * hi;
    const GAS bf16* W1T = (const GAS bf16*)(F.wsb() + WS_W1T) + (size_t)sel * HD * 4096 + (size_t)r32 * 4096 + 8 * hi;
    f32x16 acc[4];
#pragma unroll
    for (int cb = 0; cb < 4; ++cb) acc[cb] = (f32x16){};
#pragma unroll 1
    for (int li = 4 * F.wave; li < 4 * F.wave + 4; ++li) {
        bf16x8 bfr[8];
#pragma unroll
        for (int q = 0; q < 8; ++q) bfr[q] = ld16(brow + (size_t)li * NPROJ + 16 * q);
#pragma unroll
        for (int q = 0; q < 8; ++q) { const int s = li * 8 + q;
#pragma unroll
            for (int cb = 0; cb < 4; ++cb) acc[cb] = MFMA32(ld16(W1T + (size_t)cb * 32 * 4096 + 16 * s), bfr[q], acc[cb]); }
    }
    LAS float* part = (LAS float*)(F.lds + RING_OFF + F.wave * 16384);
#pragma unroll
    for (int cb = 0; cb < 4; ++cb)
#pragma unroll
        for (int r = 0; r < 16; ++r) part[(cb * 16 + r) * 64 + lane] = acc[cb][r];
    LDS_WAIT();
    __syncthreads();
    if (F.wave != 0) { __syncthreads(); return; }
#pragma unroll 1
    for (int w = 1; w < NWAVES; ++w) { const LAS float* pw = (const LAS float*)(F.lds + RING_OFF + w * 16384);
#pragma unroll
        for (int cb = 0; cb < 4; ++cb)
#pragma unroll
            for (int r = 0; r < 16; ++r) acc[cb][r] += pw[(cb * 16 + r) * 64 + lane]; }
    LAS float* bl = (LAS float*)(F.lds + FL_OFF);
    { const GAS float* cbp = (const GAS float*)(F.wsb() + WS_CBP) + (size_t)sel * 16 * HD; float b0 = 0.f, b1 = 0.f;
      for (int ch = 0; ch < 16; ++ch) { b0 += cbp[ch * HD + lane]; b1 += cbp[ch * HD + 64 + lane]; }
      bl[lane] = b0; bl[64 + lane] = b1; }
    LDS_WAIT();
    bf16x8 hb[4][2];
#pragma unroll
    for (int cb = 0; cb < 4; ++cb) { float hv[16];
#pragma unroll
        for (int r = 0; r < 16; ++r) hv[r] = pg8::silu_f(acc[cb][r] + bl[32 * cb + crow(r, hi)]);
        hb[cb][0] = pack8f(hv[0], hv[1], hv[2], hv[3], hv[4], hv[5], hv[6], hv[7]); hb[cb][1] = pack8f(hv[8], hv[9], hv[10], hv[11], hv[12], hv[13], hv[14], hv[15]); }
    LDS_WAIT();
    const GAS bf16* W2T = (const GAS bf16*)(F.wsb() + WS_W2T) + (size_t)sel * HD * HD + (size_t)r32 * HD + 4 * hi;
    f32x16 o2[4];
#pragma unroll
    for (int c2b = 0; c2b < 4; ++c2b) { o2[c2b] = (f32x16){};
        bf16x8 wf[8];
#pragma unroll
        for (int i = 0; i < 8; ++i) wf[i] = ld8x2(W2T + (size_t)c2b * 32 * HD + 32 * (i >> 1) + 16 * (i & 1));
#pragma unroll
        for (int i = 0; i < 8; ++i) o2[c2b] = MFMA32(wf[i], hb[i >> 1][i & 1], o2[c2b]); }
    if (sel == 0) {
        float ss = 0.f;
#pragma unroll
        for (int c2b = 0; c2b < 4; ++c2b)
#pragma unroll
            for (int r = 0; r < 16; ++r) ss += o2[c2b][r] * o2[c2b][r];
        ss = sum32(ss);
        const float rs = 1.0f / sqrtf(ss * (1.f / HD) + RMS_EPS); const GAS float* kn = F.inp(I_NKN) + (size_t)(l * 3) * HD;
        GAS bf16* dst = (GAS bf16*)(F.wsb() + WS_KCB) + ((size_t)(b * NHKV + hkv) * 128 + n) * HD;
#pragma unroll
        for (int c2b = 0; c2b < 4; ++c2b)
#pragma unroll
            for (int g = 0; g < 4; ++g) { const int c2 = 32 * c2b + 8 * g + 4 * hi; const f32x4 gn = *(const GAS f32x4*)(kn + c2);
                v2u w; w.x = pk2(o2[c2b][4 * g] * rs * gn.x, o2[c2b][4 * g + 1] * rs * gn.y); w.y = pk2(o2[c2b][4 * g + 2] * rs * gn.z, o2[c2b][4 * g + 3] * rs * gn.w);
                if (n == 127) { w.x = 0u; w.y = 0u; }
                *(GAS v2u*)(dst + c2) = w; }
    } else {
        GAS bf16* dst = (GAS bf16*)(F.wsb() + WS_VCT) + (size_t)(b * NHKV + hkv) * HD * 128 + n;
#pragma unroll
        for (int c2b = 0; c2b < 4; ++c2b)
#pragma unroll
            for (int r = 0; r < 16; ++r) dst[(size_t)(32 * c2b + crow(r, hi)) * 128] = (n == 127) ? (bf16)0 : (bf16)f2bf(o2[c2b][r]);
    }
    __syncthreads();
}

__device__ __forceinline__ void load_q(const GAS bf16* qrow, const LAS float* qn, int hi, bf16x8 (&qf)[8], float& qnorm) {
    v4u raw[8]; float ss = 0.f;
#pragma unroll
    for (int ks = 0; ks < 8; ++ks) raw[ks] = *(const GAS v4u*)(qrow + 16 * ks + 8 * hi);
    asm volatile("" ::: "memory");
#pragma unroll
    for (int ks = 0; ks < 8; ++ks)
#pragma unroll
        for (int i = 0; i < 4; ++i) { const float a = bflo(raw[ks][i]), b = bfhi(raw[ks][i]); ss += a * a + b * b; }
    ss = sum32(ss);
    const float rs = (1.0f / sqrtf(ss * (1.f / HD) + RMS_EPS)) * 0.08838834764831845f;
    float n2 = 0.f;
#pragma unroll
    for (int ks = 0; ks < 8; ++ks) { const f32x4 g0 = *(const LAS f32x4*)(qn + 16 * ks + 8 * hi), g1 = *(const LAS f32x4*)(qn + 16 * ks + 8 * hi + 4);
        float f[8];
#pragma unroll
        for (int i = 0; i < 4; ++i) { f[2 * i] = bflo(raw[ks][i]) * rs; f[2 * i + 1] = bfhi(raw[ks][i]) * rs; }
        f[0] *= g0.x; f[1] *= g0.y; f[2] *= g0.z; f[3] *= g0.w; f[4] *= g1.x; f[5] *= g1.y; f[6] *= g1.z; f[7] *= g1.w;
#pragma unroll
        for (int i = 0; i < 8; ++i) n2 += f[i] * f[i];
        qf[ks] = pack8f(f[0], f[1], f[2], f[3], f[4], f[5], f[6], f[7]); }
    n2 = sum32(n2);
    qnorm = sqrtf(n2);
}

__device__ __forceinline__ void nsa_select_unit(Frame& F, int l, int item, LAS float* wl, const LAS float* btab2, float kmax, float bmax) {
    const int lane = F.lane(), r32 = lane & 31, hi = lane >> 5;
    const int tt = item & 63, r1 = item >> 6, hkv = r1 & 1, b = r1 >> 1, t = 32 * tt + r32; const size_t m = (size_t)b * SEQ + t;
    const GAS bf16* P = (const GAS bf16*)(F.wsb() + WS_PROJ);
    const GAS bf16* KCB = (const GAS bf16*)(F.wsb() + WS_KCB) + (size_t)(b * NHKV + hkv) * 128 * HD + (size_t)r32 * HD + 8 * hi;
#pragma unroll 1
    for (int g = 0; g < 3; ++g) { const int h = hkv * 3 + g; const LAS float* bt = btab2 + h * 132;
        bf16x8 qf[8]; float qnorm;
        load_q(P + m * NPROJ + PC_NQ + h * HD, (const LAS float*)(F.lds + BTAB_OFF + 3200), hi, qf, qnorm);
        const float shift = -(qnorm * kmax + bmax) * LOG2E;
        f32x16 p[4]; float ls = 0.f;
#pragma unroll
        for (int nb = 0; nb < 4; ++nb) { p[nb] = (f32x16){};
#pragma unroll
            for (int k4 = 0; k4 < 2; ++k4) { bf16x8 kf[4];
#pragma unroll
                for (int ks = 0; ks < 4; ++ks) kf[ks] = ld16(KCB + (size_t)nb * 32 * HD + 16 * (4 * k4 + ks));
#pragma unroll
                for (int ks = 0; ks < 4; ++ks) p[nb] = MFMA32(kf[ks], qf[4 * k4 + ks], p[nb]); }
#pragma unroll
            for (int r = 0; r < 16; ++r) { const int n = 32 * nb + crow(r, hi); const int dist = t - 16 * n - 31; const int di = dist < 0 ? 0 : (dist > 128 ? 128 : dist);
                const float tb = bt[di] + shift; const float ee = __builtin_amdgcn_exp2f(__builtin_fmaf(p[nb][r], LOG2E, tb)); const float e = dist >= 0 ? ee : 0.f; p[nb][r] = e; ls += e; } }
        ls = sum32(ls);
        const float inv = ls > 0.f ? 1.0f / ls : 0.f;
#pragma unroll
        for (int nb = 0; nb < 4; ++nb)
#pragma unroll
            for (int r = 0; r < 16; ++r) { LAS float* w = wl + (32 * nb + crow(r, hi)) * 32 + r32; const float v = p[nb][r] * inv; *w = (g == 0) ? v : (*w + v); }
    }
    LDS_WAIT();
    float val[32];
#pragma unroll
    for (int j = 0; j < 32; ++j) val[j] = 0.f;
#pragma unroll
    for (int n = 0; n < 127; ++n) { const float v = wl[n * 32 + r32]; val[n >> 2] += v; if ((n & 3) == 3 && (n >> 2) + 1 < 32) val[(n >> 2) + 1] += v; }
    const int cur = t >> 6;
#pragma unroll
    for (int j = 0; j < 32; ++j) val[j] = (j > cur) ? -1.0f : ((j == 0 || j == cur || j == cur - 1) ? 1.0e4f : val[j]);
    unsigned mask = 0u;
#pragma unroll 1
    for (int itx = 0; itx < 8; ++itx) { float best = val[0]; int bj = 0;
#pragma unroll
        for (int j = 1; j < 32; ++j) if (val[j] > best) { best = val[j]; bj = j; }
        mask |= 1u << bj;
#pragma unroll
        for (int j = 0; j < 32; ++j) val[j] = (j == bj) ? -3.0e38f : val[j]; }
    if (hi == 0) ((GAS unsigned*)(F.wsb() + WS_SEL))[(size_t)(b * NHKV + hkv) * SEQ + t] = mask;
    LDS_WAIT();
}

template <int KIND  >
__device__ __forceinline__ float attn_softmax_tile(f32x16& p, int base, int t, int t0, int hi, float shift, float farb, const LAS float* bt, bool rowsel) {
    const bool nearb = (KIND == 0) ? true : ((t0 - base - 31) < 128);
    if (nearb) {
#pragma unroll
        for (int r = 0; r < 16; ++r) { const int c = crow(r, hi); const int d0 = (KIND == 0) ? (t - 16 * (base + c) - 31) : (t - (base + c)); const int i0 = d0 < 0 ? 0 : (d0 > 128 ? 128 : d0); p[r] = __builtin_fmaf(p[r], LOG2E, bt[i0] + shift); }
    } else {
#pragma unroll
        for (int r = 0; r < 16; ++r) p[r] = __builtin_fmaf(p[r], LOG2E, farb);
    }
    float ps = 0.f;
#pragma unroll
    for (int r = 0; r < 16; ++r) {
        const int c = crow(r, hi);
        const int d0 = (KIND == 0) ? (t - 16 * (base + c) - 31) : (t - (base + c));
        const bool v0 = (KIND == 0) ? (d0 >= 0) : ((KIND == 1) ? (rowsel && d0 >= 0) : ((unsigned)d0 < 512u));
        const float e = __builtin_amdgcn_exp2f(p[r]);
        const float e0 = v0 ? e : 0.f;
        p[r] = e0; ps += e0;
    }
    return ps;
}
__device__ __forceinline__ void attn_branch_end(f32x16 (&O)[4], float& lsum, float gate, LAS unsigned* yl, LAS float* fl, int lane, int r32, int hi, bool first) {
    float lt = sum32(lsum);
    const float f = lt > 0.f ? gate / lt : 0.f;
    if (hi == 0) fl[r32] = f;
    LDS_WAIT();
    float fr[16];
#pragma unroll
    for (int r = 0; r < 16; ++r) fr[r] = fl[crow(r, hi)];
#pragma unroll
    for (int db = 0; db < 4; ++db)
#pragma unroll
        for (int r2 = 0; r2 < 8; ++r2) { LAS unsigned* y = yl + (db * 8 + r2) * 64 + lane; float v0 = O[db][2 * r2] * fr[2 * r2], v1 = O[db][2 * r2 + 1] * fr[2 * r2 + 1];
            if (!first) { const unsigned w = *y; v0 += bflo(w); v1 += bfhi(w); }
            *y = pg8::cvt_pk_bf16(v0, v1); }
#pragma unroll
    for (int db = 0; db < 4; ++db) O[db] = (f32x16){};
    lsum = 0.f;
    LDS_WAIT();
}
__device__ __forceinline__ void nsa_attn_block(Frame& F, int l, int unit, int g, const LAS float* btab2, float kmax, float bmax) {
    const int lane = F.lane(), r32 = lane & 31, hi = lane >> 5, w = F.wave;
    const unsigned lo8 = (unsigned)lane * 8u;
    const int qb = 7 - unit / 32, grp = unit % 32, b = grp >> 1, hkv = grp & 1, T0 = qb * 256, t0 = T0 + 32 * w, t = t0 + r32; const size_t m = (size_t)b * SEQ + t;
    const GAS bf16* P = (const GAS bf16*)(F.wsb() + WS_PROJ);
    LAS bf16* kb = (LAS bf16*)(F.lds + RING_OFF); LAS bf16* vb = (LAS bf16*)(F.lds + RING_OFF + 16384);
    LAS unsigned* yl = (LAS unsigned*)(F.lds + RING_OFF + 32768 + w * 8192); LAS float* fl = (LAS float*)(F.lds + FL_OFF + w * 1024);
    const GAS bf16* KC = (const GAS bf16*)(F.wsb() + WS_KCB) + (size_t)(b * NHKV + hkv) * 128 * HD; const GAS bf16* VC = (const GAS bf16*)(F.wsb() + WS_VCT) + (size_t)(b * NHKV + hkv) * HD * 128;
    const GAS bf16* KSn = (const GAS bf16*)(F.wsb() + WS_KN) + (size_t)((0 * NBATCH + b) * NHKV + hkv) * 64 * 4096; const GAS bf16* KWn = (const GAS bf16*)(F.wsb() + WS_KN) + (size_t)((1 * NBATCH + b) * NHKV + hkv) * 64 * 4096;
    const GAS bf16* VSn = (const GAS bf16*)(F.wsb() + WS_VT) + (size_t)((0 * NBATCH + b) * NHKV + hkv) * 64 * 4096; const GAS bf16* VWn = (const GAS bf16*)(F.wsb() + WS_VT) + (size_t)((1 * NBATCH + b) * NHKV + hkv) * 64 * 4096;
    const unsigned mymask = ((const GAS unsigned*)(F.wsb() + WS_SEL))[(size_t)(b * NHKV + hkv) * SEQ + t];
    unsigned unw = wave_or(mymask); unw = (unsigned)__builtin_amdgcn_readfirstlane((int)unw);
    const int curmax = (T0 + 255) >> 6, ns = 2 * (curmax + 1), ilo = (T0 - 511 > 0 ? T0 - 511 : 0) >> 5, ihi = (T0 + 255) >> 5, total = ns + (ihi - ilo + 1);
    {
        const int h = hkv * 3 + g; const LAS float* bt = btab2 + h * 132;
        bf16x8 qf[8]; float qnorm;
        load_q(P + m * NPROJ + PC_NQ + h * HD, (const LAS float*)(F.lds + BTAB_OFF + 3200), hi, qf, qnorm);
        const float shift = -(qnorm * kmax + bmax) * LOG2E, farb = bt[128] + shift;
        f32x16 O[4];
#pragma unroll
        for (int db = 0; db < 4; ++db) O[db] = (f32x16){};
        float lsum = 0.f;
        { const int nvis = (t0 >> 4) + 1; int cnt = (nvis + 31) >> 5; if (cnt > 4) cnt = 4;
#pragma unroll 1
          for (int ti = 0; ti < cnt; ++ti) { const int base = 32 * ti;
              bf16x8 kf[8], vf[8];
#pragma unroll
              for (int ks = 0; ks < 8; ++ks) kf[ks] = ld16(KC + (size_t)(base + r32) * HD + 8 * hi + 16 * ks);
#pragma unroll
              for (int db = 0; db < 4; ++db)
#pragma unroll
                  for (int ks = 0; ks < 2; ++ks) vf[db * 2 + ks] = ld8x2(VC + (size_t)(32 * db + r32) * 128 + base + 16 * ks + 4 * hi);
              f32x16 p = (f32x16){};
#pragma unroll
              for (int ks = 0; ks < 8; ++ks) p = MFMA32(kf[ks], qf[ks], p);
              lsum += attn_softmax_tile<0>(p, base, t, t0, hi, shift, farb, bt, true);
              const bf16x8 pa0 = pack8f(p[0], p[1], p[2], p[3], p[4], p[5], p[6], p[7]), pa1 = pack8f(p[8], p[9], p[10], p[11], p[12], p[13], p[14], p[15]);
#pragma unroll
              for (int db = 0; db < 4; ++db) { O[db] = MFMA32(pa0, vf[db * 2], O[db]); O[db] = MFMA32(pa1, vf[db * 2 + 1], O[db]); } }
          const float g0 = sigmoid_f(bf2f(P[m * NPROJ + PC_NG + 0 * 6 + h]));
          attn_branch_end(O, lsum, g0, yl, fl, lane, r32, hi, true); }
        __syncthreads();
        { const GAS bf16* ks0 = KSn + (size_t)w * 512 + lo8; const GAS bf16* vs0 = VSn + (size_t)w * 512 + lo8;
          *(LAS v4u*)(kb + w * 512 + lo8) = *(const GAS v4u*)ks0; *(LAS v4u*)(vb + w * 512 + lo8) = *(const GAS v4u*)vs0; }
#pragma unroll 1
        for (int idx = 0; idx < total; ++idx) {
            __syncthreads();
            const bool issel = idx < ns; const int base = issel ? 32 * idx : 32 * (ilo + idx - ns);
            v4u kr, vr; const bool nxt = idx + 1 < total;
            if (nxt) { const int i1 = idx + 1; const bool s1 = i1 < ns; const int tile1 = s1 ? i1 : (ilo + i1 - ns);
                kr = *(const GAS v4u*)((s1 ? KSn : KWn) + (size_t)tile1 * 4096 + w * 512 + lo8); vr = *(const GAS v4u*)((s1 ? VSn : VWn) + (size_t)tile1 * 4096 + w * 512 + lo8); }
            const LAS bf16* kt = kb + (idx & 1) * 4096; const LAS bf16* vt = vb + (idx & 1) * 4096;
            const bool need = issel ? ((((unw >> (base >> 6)) & 1u) != 0u) && base <= t0 + 31) : (base + 31 >= t0 - 511 && base <= t0 + 31);
            if (need) {
                f32x16 p = (f32x16){};
                { bf16x8 k4[4];
#pragma unroll
                  for (int ks = 0; ks < 4; ++ks) k4[ks] = *(const LAS bf16x8*)(kt + ks * 512 + lo8);
#pragma unroll
                  for (int ks = 0; ks < 4; ++ks) p = MFMA32(k4[ks], qf[ks], p);
#pragma unroll
                  for (int ks = 0; ks < 4; ++ks) k4[ks] = *(const LAS bf16x8*)(kt + (4 + ks) * 512 + lo8);
#pragma unroll
                  for (int ks = 0; ks < 4; ++ks) p = MFMA32(k4[ks], qf[4 + ks], p); }
                lsum += issel ? attn_softmax_tile<1>(p, base, t, t0, hi, shift, farb, bt, ((mymask >> (base >> 6)) & 1u) != 0u) : attn_softmax_tile<2>(p, base, t, t0, hi, shift, farb, bt, true);
                const bf16x8 pa0 = pack8f(p[0], p[1], p[2], p[3], p[4], p[5], p[6], p[7]), pa1 = pack8f(p[8], p[9], p[10], p[11], p[12], p[13], p[14], p[15]);
#pragma unroll
                for (int db = 0; db < 4; ++db) { const bf16x8 v0 = *(const LAS bf16x8*)(vt + (db * 2) * 512 + lo8), v1 = *(const LAS bf16x8*)(vt + (db * 2 + 1) * 512 + lo8);
                    O[db] = MFMA32(pa0, v0, O[db]); O[db] = MFMA32(pa1, v1, O[db]); }
            }
            if (idx == ns - 1) { const float g1 = sigmoid_f(bf2f(P[m * NPROJ + PC_NG + 1 * 6 + h])); attn_branch_end(O, lsum, g1, yl, fl, lane, r32, hi, false); }
            if (nxt) { *(LAS v4u*)(kb + ((idx + 1) & 1) * 4096 + w * 512 + lo8) = kr; *(LAS v4u*)(vb + ((idx + 1) & 1) * 4096 + w * 512 + lo8) = vr; }
        }
        { const float g2 = sigmoid_f(bf2f(P[m * NPROJ + PC_NG + 2 * 6 + h])); float lt = sum32(lsum); const float f = lt > 0.f ? g2 / lt : 0.f;
          if (hi == 0) fl[r32] = f;
          LDS_WAIT();
          int lane2 = lane; asm volatile("" : "+v"(lane2));
          const int r32b = lane2 & 31, hib = lane2 >> 5;
          GAS bf16* Y = (GAS bf16*)(F.wsb() + WS_H) + ((size_t)b * SEQ + t0) * DM + 768 + h * HD + r32b + (size_t)(4 * hib) * DM;
#pragma unroll
          for (int r2 = 0; r2 < 8; ++r2) { const float fq0 = fl[crow(2 * r2, 0) + 4 * hib], fq1 = fl[crow(2 * r2 + 1, 0) + 4 * hib];
#pragma unroll
              for (int db = 0; db < 4; ++db) { const unsigned yw = yl[(db * 8 + r2) * 64 + lane2]; const float v0 = bflo(yw) + O[db][2 * r2] * fq0, v1 = bfhi(yw) + O[db][2 * r2 + 1] * fq1; const float n0 = xl1(v0), n1 = xl1(v1);
                  if ((r32b & 1) == 0) { *(GAS unsigned*)(Y + (size_t)crow(2 * r2, 0) * DM + 32 * db) = pk2(v0, n0); *(GAS unsigned*)(Y + (size_t)crow(2 * r2 + 1, 0) * DM + 32 * db) = pk2(v1, n1); } } }
          LDS_WAIT(); }
    }
    __syncthreads();
}

__device__ __forceinline__ float softplus_f(float x) { return fmaxf(x, 0.f) + __logf(1.0f + __expf(-fabsf(x))); }
__device__ __forceinline__ void ph_mix1(Frame& F, int l) {
    const int gw = F.vcu * NWAVES + F.wave, NGW = F.G * NWAVES, lane = F.lane();
    const GAS bf16* P = (const GAS bf16*)(F.wsb() + WS_PROJ);
    {
        GAS bf16* GQ = (GAS bf16*)(F.wsb() + WS_GQ); GAS bf16* GK = (GAS bf16*)(F.wsb() + WS_GK); GAS bf16* GV = (GAS bf16*)(F.wsb() + WS_GV);
        GAS float* GB = (GAS float*)(F.wsb() + WS_GBG); GAS float* GG = GB + NBATCH * GH * SEQ;
        const GAS float* cw = F.inp(I_GCONV) + (size_t)l * 2304 * 4;
        for (int it = gw; it < NBATCH * (SEQ / 8) * GH; it += NGW) {
            const int h = it % GH, r1 = it / GH, tb = r1 % (SEQ / 8), b = r1 / (SEQ / 8), t0 = tb * 8; const size_t m0 = (size_t)b * SEQ + t0;
            unsigned raw[3][11];
#pragma unroll
            for (int p = 0; p < 3; ++p)
#pragma unroll
                for (int j = 0; j < 11; ++j) { const int tt = t0 - 3 + j; raw[p][j] = (tt >= 0) ? *(const GAS unsigned*)(P + (m0 - 3 + j) * NPROJ + PC_GQKV + p * 768 + h * 128 + 2 * lane) : 0u; }
            float bb = 0.f, aa = 0.f;
            if (lane < 8) { bb = bf2f(P[(m0 + lane) * NPROJ + PC_GB + h]); aa = bf2f(P[(m0 + lane) * NPROJ + PC_GA + h]); }
            f32x4 w0[3], w1[3];
#pragma unroll
            for (int p = 0; p < 3; ++p) { const int ch = p * 768 + h * 128 + 2 * lane; w0[p] = *(const GAS f32x4*)(cw + (size_t)ch * 4); w1[p] = *(const GAS f32x4*)(cw + (size_t)(ch + 1) * 4); }
            const size_t o0 = ((size_t)(b * GH + h) * SEQ + t0) * HD + 2 * lane;
#pragma unroll
            for (int i = 0; i < 8; ++i) {
                float val[3][2];
#pragma unroll
                for (int p = 0; p < 3; ++p) { float a0 = 0.f, a1 = 0.f;
#pragma unroll
                    for (int j = 0; j < 4; ++j) { a0 += bflo(raw[p][i + j]) * w0[p][j]; a1 += bfhi(raw[p][i + j]) * w1[p][j]; }
                    val[p][0] = pg8::silu_f(a0); val[p][1] = pg8::silu_f(a1); }
                const float sq = wave_sum(val[0][0] * val[0][0] + val[0][1] * val[0][1]), sk = wave_sum(val[1][0] * val[1][0] + val[1][1] * val[1][1]);
                const float rq = (1.0f / sqrtf(sq + RMS_EPS)) * 0.08838834764831845f, rk = 1.0f / sqrtf(sk + RMS_EPS);
                *(GAS unsigned*)(GQ + o0 + (size_t)i * HD) = pk2(val[0][0] * rq, val[0][1] * rq);
                *(GAS unsigned*)(GK + o0 + (size_t)i * HD) = pk2(val[1][0] * rk, val[1][1] * rk);
                *(GAS unsigned*)(GV + o0 + (size_t)i * HD) = pk2(val[2][0], val[2][1]);
            }
            if (lane < 8) {
                GB[(size_t)(b * GH + h) * SEQ + t0 + lane] = sigmoid_f(bb);
                GG[(size_t)(b * GH + h) * SEQ + t0 + lane] = -__expf(F.inp(I_GALOG)[l * GH + h]) * softplus_f(aa + F.inp(I_GDT)[l * GH + h]);
            }
        }
    }
    __syncthreads();
    for (int it = F.vcu; it < 2 * NBATCH * NHKV * 4; it += F.G) cmp_unit(F, l, it);
}

__device__ __forceinline__ void gdn_chunk_unit(Frame& F, int item, LAS float* wl, LAS float* sl) {
    const int lane = F.lane(), r32 = lane & 31, hi = lane >> 5;
    const size_t tok0 = (size_t)item * 64;
    GAS bf16* GQ = (GAS bf16*)(F.wsb() + WS_GQ) + tok0 * HD; GAS bf16* GK = (GAS bf16*)(F.wsb() + WS_GK) + tok0 * HD; GAS bf16* GV = (GAS bf16*)(F.wsb() + WS_GV) + tok0 * HD;
    const GAS float* GB = (const GAS float*)(F.wsb() + WS_GBG) + tok0; const GAS float* GG = GB + NBATCH * GH * SEQ;
    float gc = GG[lane]; const float beta = GB[lane];
#pragma unroll
    for (int o = 1; o < 64; o <<= 1) { const float v = __int_as_float(__builtin_amdgcn_ds_bpermute((lane - o) << 2, __float_as_int(gc))); if (lane >= o) gc += v; }
    const float glast = rl(gc, 63);
    sl[lane] = gc; sl[64 + lane] = beta; sl[128 + lane] = __expf(gc); sl[192 + lane] = __expf(glast - gc);
    if (lane == 0) ((GAS float*)(F.wsb() + WS_EGL))[item] = __expf(glast);
    LDS_WAIT();
    {
        bf16x8 kfr[2][8];
#pragma unroll
        for (int rb = 0; rb < 2; ++rb)
#pragma unroll
            for (int ks = 0; ks < 8; ++ks) kfr[rb][ks] = ld16(GK + (size_t)(32 * rb + r32) * HD + 16 * ks + 8 * hi);
#pragma unroll
        for (int tI = 0; tI < 3; ++tI) { const int rb = (tI == 2) ? 1 : 0, cb = (tI == 0) ? 0 : 1;
            f32x16 acc = (f32x16){};
#pragma unroll
            for (int ks = 0; ks < 8; ++ks) acc = MFMA32(kfr[rb][ks], kfr[cb][ks], acc);
            const int s_ = 32 * cb + r32; const float gcs = sl[s_], bs = sl[64 + s_];
#pragma unroll
            for (int r = 0; r < 16; ++r) { const int c = 32 * rb + crow(r, hi); wl[c * 64 + s_] = (s_ > c) ? bs * acc[r] * __expf(gcs - sl[c]) : 0.f; }
        }
        GAS bf16* ATT = (GAS bf16*)(F.wsb() + WS_ATT) + (size_t)item * 4096;
#pragma unroll
        for (int ib = 0; ib < 2; ++ib) {
            bf16x8 qfr[8];
#pragma unroll
            for (int ks = 0; ks < 8; ++ks) qfr[ks] = ld16(GQ + (size_t)(32 * ib + r32) * HD + 16 * ks + 8 * hi);
            const int i_ = 32 * ib + r32; const float gci = sl[i_];
#pragma unroll
            for (int jb = 0; jb < 2; ++jb) { f32x16 acc = (f32x16){};
                if (!(ib == 0 && jb == 1)) {
#pragma unroll
                    for (int ks = 0; ks < 8; ++ks) acc = MFMA32(kfr[jb][ks], qfr[ks], acc);
                }
                float av[16];
#pragma unroll
                for (int r = 0; r < 16; ++r) { const int j_ = 32 * jb + crow(r, hi); av[r] = (j_ <= i_) ? acc[r] * __expf(gci - sl[j_]) : 0.f; }
                *(GAS bf16x8*)(ATT + ((ib * 4 + jb * 2 + 0) * 64 + lane) * 8) = pack8f(av[0], av[1], av[2], av[3], av[4], av[5], av[6], av[7]);
                *(GAS bf16x8*)(ATT + ((ib * 4 + jb * 2 + 1) * 64 + lane) * 8) = pack8f(av[8], av[9], av[10], av[11], av[12], av[13], av[14], av[15]); }
        }
    }
    LDS_WAIT();
    float yv[64];
#pragma unroll
    for (int c = 63; c >= 0; --c) {
        float acc = (c == lane) ? 1.0f : 0.0f;
#pragma unroll
        for (int s4 = ((c + 1) & ~3); s4 < 64; s4 += 4) { const f32x4 mv = *(const LAS f32x4*)(wl + c * 64 + s4);
            if (s4 + 0 > c) acc = __builtin_fmaf(-mv.x, yv[s4 + 0], acc); if (s4 + 1 > c) acc = __builtin_fmaf(-mv.y, yv[s4 + 1], acc); if (s4 + 2 > c) acc = __builtin_fmaf(-mv.z, yv[s4 + 2], acc); if (s4 + 3 > c) acc = __builtin_fmaf(-mv.w, yv[s4 + 3], acc); }
        yv[c] = acc;
        asm volatile("" ::: "memory");
    }
    unsigned au[4][2][4], aw[4][2][4];
#pragma unroll
    for (int ks = 0; ks < 4; ++ks) { unsigned pu[8], pw[8];
#pragma unroll
        for (int d = 0; d < 8; ++d) { const int c0 = 16 * ks + 2 * d; const float b0 = sl[64 + c0], b1 = sl[64 + c0 + 1], e0 = sl[128 + c0], e1 = sl[128 + c0 + 1];
            pu[d] = pg8::cvt_pk_bf16(yv[c0] * b0, yv[c0 + 1] * b1); pw[d] = pg8::cvt_pk_bf16(yv[c0] * b0 * e0, yv[c0 + 1] * b1 * e1); }
#pragma unroll
        for (int i = 0; i < 4; ++i) { auto ru = __builtin_amdgcn_permlane32_swap(pu[i], pu[4 + i], false, false); au[ks][0][i] = ru[0]; au[ks][1][i] = ru[1];
            auto rw = __builtin_amdgcn_permlane32_swap(pw[i], pw[4 + i], false, false); aw[ks][0][i] = rw[0]; aw[ks][1][i] = rw[1]; } }
    LDS_WAIT();
    LAS bf16* tl = (LAS bf16*)wl;
    {
#pragma unroll
        for (int i = 0; i < 16; ++i) { const int row = 4 * i + (lane >> 4), chn = lane & 15; *(LAS v4u*)(tl + row * HD + 8 * chn) = *(const GAS v4u*)(GV + (size_t)row * HD + 8 * chn); }
        LDS_WAIT();
        GAS bf16* GU = (GAS bf16*)(F.wsb() + WS_GU) + (size_t)item * 8192;
#pragma unroll 1
        for (int eb = 0; eb < 4; ++eb) { f32x16 a0 = (f32x16){}, a1 = (f32x16){};
#pragma unroll
            for (int ks = 0; ks < 4; ++ks) { unsigned w[4];
#pragma unroll
                for (int j = 0; j < 4; ++j) w[j] = (unsigned)tl[(16 * ks + 8 * hi + 2 * j) * HD + 32 * eb + r32] | ((unsigned)tl[(16 * ks + 8 * hi + 2 * j + 1) * HD + 32 * eb + r32] << 16);
                v4u bw; bw.x = w[0]; bw.y = w[1]; bw.z = w[2]; bw.w = w[3]; const bf16x8 bfr = __builtin_bit_cast(bf16x8, bw);
                v4u x0; x0.x = au[ks][0][0]; x0.y = au[ks][0][1]; x0.z = au[ks][0][2]; x0.w = au[ks][0][3]; v4u x1; x1.x = au[ks][1][0]; x1.y = au[ks][1][1]; x1.z = au[ks][1][2]; x1.w = au[ks][1][3];
                a0 = MFMA32(__builtin_bit_cast(bf16x8, x0), bfr, a0); a1 = MFMA32(__builtin_bit_cast(bf16x8, x1), bfr, a1); }
            for (int hf = 0; hf < 2; ++hf) { v4u w0, w1;
                w0.x = pg8::cvt_pk_bf16(a0[8 * hf + 0], a0[8 * hf + 1]); w0.y = pg8::cvt_pk_bf16(a0[8 * hf + 2], a0[8 * hf + 3]); w0.z = pg8::cvt_pk_bf16(a0[8 * hf + 4], a0[8 * hf + 5]); w0.w = pg8::cvt_pk_bf16(a0[8 * hf + 6], a0[8 * hf + 7]);
                w1.x = pg8::cvt_pk_bf16(a1[8 * hf + 0], a1[8 * hf + 1]); w1.y = pg8::cvt_pk_bf16(a1[8 * hf + 2], a1[8 * hf + 3]); w1.z = pg8::cvt_pk_bf16(a1[8 * hf + 4], a1[8 * hf + 5]); w1.w = pg8::cvt_pk_bf16(a1[8 * hf + 6], a1[8 * hf + 7]);
                *(GAS v4u*)(GU + ((eb * 2 + 0) * 64 + lane) * 16 + 8 * hf) = w0; *(GAS v4u*)(GU + ((eb * 2 + 1) * 64 + lane) * 16 + 8 * hf) = w1; } }
        LDS_WAIT();
    }
    {
#pragma unroll
        for (int i = 0; i < 16; ++i) { const int row = 4 * i + (lane >> 4), chn = lane & 15; *(LAS v4u*)(tl + row * HD + 8 * chn) = *(const GAS v4u*)(GK + (size_t)row * HD + 8 * chn); }
        LDS_WAIT();
#pragma unroll 1
        for (int db = 0; db < 4; ++db) { f32x16 a0 = (f32x16){}, a1 = (f32x16){};
#pragma unroll
            for (int ks = 0; ks < 4; ++ks) { unsigned w[4];
#pragma unroll
                for (int j = 0; j < 4; ++j) w[j] = (unsigned)tl[(16 * ks + 8 * hi + 2 * j) * HD + 32 * db + r32] | ((unsigned)tl[(16 * ks + 8 * hi + 2 * j + 1) * HD + 32 * db + r32] << 16);
                v4u bw; bw.x = w[0]; bw.y = w[1]; bw.z = w[2]; bw.w = w[3]; const bf16x8 kT = __builtin_bit_cast(bf16x8, bw);
                v4u x0; x0.x = aw[ks][0][0]; x0.y = aw[ks][0][1]; x0.z = aw[ks][0][2]; x0.w = aw[ks][0][3]; v4u x1; x1.x = aw[ks][1][0]; x1.y = aw[ks][1][1]; x1.z = aw[ks][1][2]; x1.w = aw[ks][1][3];
                a0 = MFMA32(kT, __builtin_bit_cast(bf16x8, x0), a0); a1 = MFMA32(kT, __builtin_bit_cast(bf16x8, x1), a1); }
#pragma unroll
            for (int s2 = 0; s2 < 2; ++s2) {
                *(GAS bf16x8*)(GV + ((0 * 8 + db * 2 + s2) * 64 + lane) * 8) = pack8f(-a0[8 * s2 + 0], -a0[8 * s2 + 1], -a0[8 * s2 + 2], -a0[8 * s2 + 3], -a0[8 * s2 + 4], -a0[8 * s2 + 5], -a0[8 * s2 + 6], -a0[8 * s2 + 7]);
                *(GAS bf16x8*)(GV + ((1 * 8 + db * 2 + s2) * 64 + lane) * 8) = pack8f(-a1[8 * s2 + 0], -a1[8 * s2 + 1], -a1[8 * s2 + 2], -a1[8 * s2 + 3], -a1[8 * s2 + 4], -a1[8 * s2 + 5], -a1[8 * s2 + 6], -a1[8 * s2 + 7]); } }
#pragma unroll 1
        for (int db = 0; db < 4; ++db)
#pragma unroll
            for (int f = 0; f < 4; ++f) { float v[8];
#pragma unroll
                for (int j = 0; j < 8; ++j) { const int c = 32 * (f >> 1) + 16 * (f & 1) + 8 * (j >> 2) + 4 * hi + (j & 3); v[j] = bf2f(tl[c * HD + 32 * db + r32]) * sl[192 + c]; }
                *(GAS bf16x8*)(GK + ((db * 4 + f) * 64 + lane) * 8) = pack8f(v[0], v[1], v[2], v[3], v[4], v[5], v[6], v[7]); }
        LDS_WAIT();
    }
    {
        bf16x8 qa[16];
#pragma unroll
        for (int i = 0; i < 16; ++i) qa[i] = ld8x2(GQ + (size_t)(32 * (i >> 3) + r32) * HD + 32 * ((i >> 1) & 3) + 16 * (i & 1) + 4 * hi);
        const float e0 = sl[128 + r32], e1 = sl[128 + 32 + r32];
        asm volatile("s_waitcnt vmcnt(0)" ::: "memory");
#pragma unroll
        for (int i = 0; i < 16; ++i) { const float e = (i < 8) ? e0 : e1; const v4u w = __builtin_bit_cast(v4u, qa[i]);
            *(GAS bf16x8*)(GQ + (i * 64 + lane) * 8) = pack8f(bflo(w.x) * e, bfhi(w.x) * e, bflo(w.y) * e, bfhi(w.y) * e, bflo(w.z) * e, bfhi(w.z) * e, bflo(w.w) * e, bfhi(w.w) * e); }
    }
    LDS_WAIT();
}
__device__ __forceinline__ void gdn_scan_block(Frame& F, int bh) {
    const int lane = F.lane(), r32 = lane & 31, hi = lane >> 5, w = F.wave;
    const unsigned lo8 = (unsigned)lane * 8u, lo16 = (unsigned)lane * 16u;
    constexpr int IMG = 57344, O_W = 0, O_QG = 16384, O_KD = 32768, O_AT = 49152;
    LAS unsigned char* ring = F.lds + RING_OFF;
    const GAS bf16* Wg = (const GAS bf16*)(F.wsb() + WS_GV) + (size_t)bh * SEQ * HD; const GAS bf16* QGg = (const GAS bf16*)(F.wsb() + WS_GQ) + (size_t)bh * SEQ * HD;
    const GAS bf16* KDg = (const GAS bf16*)(F.wsb() + WS_GK) + (size_t)bh * SEQ * HD; const GAS bf16* ATg = (const GAS bf16*)(F.wsb() + WS_ATT) + (size_t)bh * 32 * 4096;
    __syncthreads();
    if (w >= 4) {
        const int ld = w - 4;
#pragma unroll 1
        for (int c = -1; c < 32; ++c) {
            if (c + 1 < 32) { const int cn = c + 1; LAS unsigned char* img = ring + (cn & 1) * IMG;
                v4u rw[4], rq[4], rk[4], ra[2];
#pragma unroll
                for (int i = 0; i < 4; ++i) { rw[i] = *(const GAS v4u*)(Wg + (size_t)cn * 64 * HD + (4 * ld + i) * 512 + lo8); rq[i] = *(const GAS v4u*)(QGg + (size_t)cn * 64 * HD + (4 * ld + i) * 512 + lo8);
                    rk[i] = *(const GAS v4u*)(KDg + (size_t)cn * 64 * HD + (4 * ld + i) * 512 + lo8); }
#pragma unroll
                for (int i = 0; i < 2; ++i) ra[i] = *(const GAS v4u*)(ATg + (size_t)cn * 4096 + (2 * ld + i) * 512 + lo8);
#pragma unroll
                for (int i = 0; i < 4; ++i) { *(LAS v4u*)(img + O_W + (4 * ld + i) * 1024 + lo16) = rw[i]; *(LAS v4u*)(img + O_QG + (4 * ld + i) * 1024 + lo16) = rq[i]; *(LAS v4u*)(img + O_KD + (4 * ld + i) * 1024 + lo16) = rk[i]; }
#pragma unroll
                for (int i = 0; i < 2; ++i) *(LAS v4u*)(img + O_AT + (2 * ld + i) * 1024 + lo16) = ra[i];
            }
            __syncthreads();
        }
    } else {
        const int es = w, b = bh / GH, h = bh % GH;
        f32x16 S[4];
#pragma unroll
        for (int db = 0; db < 4; ++db) S[db] = (f32x16){};
        GAS bf16* GOb = (GAS bf16*)(F.wsb() + WS_GO) + (size_t)b * SEQ * 768 + h * HD + 32 * es + r32;
        const GAS bf16* GUg = (const GAS bf16*)(F.wsb() + WS_GU) + (size_t)bh * 32 * 8192 + es * 2048; const GAS float* EG = (const GAS float*)(F.wsb() + WS_EGL) + bh * 32;
        v4u g0a = *(const GAS v4u*)(GUg + lo16), g0b = *(const GAS v4u*)(GUg + lo16 + 8), g1a = *(const GAS v4u*)(GUg + 1024 + lo16), g1b = *(const GAS v4u*)(GUg + 1024 + lo16 + 8);
        float eg = EG[0];
        __syncthreads();
#pragma unroll 1
        for (int ch = 0; ch < 32; ++ch) {
            const LAS bf16* img = (const LAS bf16*)(ring + (ch & 1) * IMG);
            const LAS bf16* Wl = img + O_W / 2 + lo8; const LAS bf16* QGl = img + O_QG / 2 + lo8; const LAS bf16* KDl = img + O_KD / 2 + lo8; const LAS bf16* ATl = img + O_AT / 2 + lo8;
            bf16x8 Sb[4][2];
#pragma unroll
            for (int db = 0; db < 4; ++db) { Sb[db][0] = pack8f(S[db][0], S[db][1], S[db][2], S[db][3], S[db][4], S[db][5], S[db][6], S[db][7]); Sb[db][1] = pack8f(S[db][8], S[db][9], S[db][10], S[db][11], S[db][12], S[db][13], S[db][14], S[db][15]); }
            f32x16 VN[2], OT[2];
#pragma unroll
            for (int i = 0; i < 4; ++i) { VN[0][2 * i] = bflo(g0a[i]); VN[0][2 * i + 1] = bfhi(g0a[i]); VN[0][8 + 2 * i] = bflo(g0b[i]); VN[0][8 + 2 * i + 1] = bfhi(g0b[i]);
                VN[1][2 * i] = bflo(g1a[i]); VN[1][2 * i + 1] = bfhi(g1a[i]); VN[1][8 + 2 * i] = bflo(g1b[i]); VN[1][8 + 2 * i + 1] = bfhi(g1b[i]); }
            const float egc = eg;
            if (ch + 1 < 32) { const GAS bf16* GUn = GUg + (size_t)(ch + 1) * 8192;
                g0a = *(const GAS v4u*)(GUn + lo16); g0b = *(const GAS v4u*)(GUn + lo16 + 8); g1a = *(const GAS v4u*)(GUn + 1024 + lo16); g1b = *(const GAS v4u*)(GUn + 1024 + lo16 + 8); eg = EG[ch + 1]; }
#pragma unroll
            for (int rb = 0; rb < 2; ++rb)
#pragma unroll
                for (int i = 0; i < 8; ++i) VN[rb] = MFMA32(*(const LAS bf16x8*)(Wl + (rb * 8 + i) * 512), Sb[i >> 1][i & 1], VN[rb]);
            bf16x8 VNb[2][2];
#pragma unroll
            for (int cb = 0; cb < 2; ++cb) { VNb[cb][0] = pack8f(VN[cb][0], VN[cb][1], VN[cb][2], VN[cb][3], VN[cb][4], VN[cb][5], VN[cb][6], VN[cb][7]); VNb[cb][1] = pack8f(VN[cb][8], VN[cb][9], VN[cb][10], VN[cb][11], VN[cb][12], VN[cb][13], VN[cb][14], VN[cb][15]); }
#pragma unroll
            for (int db = 0; db < 4; ++db) { S[db] = S[db] * egc;
#pragma unroll
                for (int j = 0; j < 4; ++j) S[db] = MFMA32(*(const LAS bf16x8*)(KDl + (db * 4 + j) * 512), VNb[j >> 1][j & 1], S[db]); }
#pragma unroll
            for (int rb = 0; rb < 2; ++rb) { OT[rb] = (f32x16){};
#pragma unroll
                for (int i = 0; i < 8; ++i) OT[rb] = MFMA32(*(const LAS bf16x8*)(QGl + (rb * 8 + i) * 512), Sb[i >> 1][i & 1], OT[rb]);
#pragma unroll
                for (int j = 0; j < 4; ++j) OT[rb] = MFMA32(*(const LAS bf16x8*)(ATl + (rb * 4 + j) * 512), VNb[j >> 1][j & 1], OT[rb]);
#pragma unroll
                for (int r = 0; r < 16; ++r) { const float v = OT[rb][r]; const float vn = xl1(v);
                    if ((r32 & 1) == 0) *(GAS unsigned*)(GOb + (size_t)(ch * 64 + 32 * rb + crow(r, hi)) * 768) = pk2(v, vn); } }
            __syncthreads();
        }
    }
}
__device__ __forceinline__ void ph_fill(Frame& F, int l, int first, int stride) {
    const int lane = F.lane();
    const GAS bf16* P = (const GAS bf16*)(F.wsb() + WS_PROJ);
    {
        GAS bf16* KN = (GAS bf16*)(F.wsb() + WS_KN);
        for (int it = first; it < NBATCH * (SEQ / 8); it += stride) {
            const int tb = it % (SEQ / 8), b = it / (SEQ / 8), t0 = tb * 8; const size_t m0 = (size_t)b * SEQ + t0;
            unsigned raw[8][4];
#pragma unroll
            for (int i = 0; i < 8; ++i)
#pragma unroll
                for (int q = 0; q < 4; ++q) raw[i][q] = *(const GAS unsigned*)(P + (m0 + i) * NPROJ + PC_NKV + (2 + 2 * (q >> 1)) * 256 + (q & 1) * 128 + 2 * lane);
            float kn[2][2];
#pragma unroll
            for (int w = 0; w < 2; ++w) { const GAS float* kp_ = F.inp(I_NKN) + (size_t)(l * 3 + 1 + w) * HD + 2 * lane; kn[w][0] = kp_[0]; kn[w][1] = kp_[1]; }
#pragma unroll
            for (int i = 0; i < 8; ++i)
#pragma unroll
                for (int q = 0; q < 4; ++q) { const int which = q >> 1, hkv = q & 1; const float a0 = bflo(raw[i][q]), a1 = bfhi(raw[i][q]);
                    const float rs = 1.0f / sqrtf(wave_sum(a0 * a0 + a1 * a1) * (1.f / HD) + RMS_EPS);
                    { const int key = t0 + i, d = 2 * lane;
                      *(GAS unsigned*)(KN + ((size_t)((which * NBATCH + b) * NHKV + hkv) * 64 + (key >> 5)) * 4096 + (((d >> 4) * 64 + (key & 31) + 32 * ((d >> 3) & 1)) * 8 + (d & 7))) = pk2(a0 * rs * kn[which][0], a1 * rs * kn[which][1]); } }
        }
    }
    {
        GAS bf16* Y = (GAS bf16*)(F.wsb() + WS_H);
        const GAS float* sw = F.inp(I_SCW) + (size_t)l * 512 * 3;
        for (int it = first; it < NBATCH * (SEQ / 8); it += stride) {
            const int tb = it % (SEQ / 8), b = it / (SEQ / 8), t0 = tb * 8; const size_t m0 = (size_t)b * SEQ + t0; const int c0 = 8 * lane;
            v4u ru[10], rc[10], rb[8];
#pragma unroll
            for (int j = 0; j < 10; ++j) { const int tt = t0 - 2 + j; if (tt >= 0) { ru[j] = *(const GAS v4u*)(P + (m0 - 2 + j) * NPROJ + PC_CU + c0); rc[j] = *(const GAS v4u*)(P + (m0 - 2 + j) * NPROJ + PC_CC + c0); } else { ru[j] = (v4u){0u, 0u, 0u, 0u}; rc[j] = (v4u){0u, 0u, 0u, 0u}; } }
#pragma unroll
            for (int i = 0; i < 8; ++i) rb[i] = *(const GAS v4u*)(P + (m0 + i) * NPROJ + PC_CB + c0);
            float wv[8][3];
#pragma unroll
            for (int c = 0; c < 8; ++c)
#pragma unroll
                for (int j = 0; j < 3; ++j) wv[c][j] = sw[(c0 + c) * 3 + j];
#pragma unroll
            for (int i = 0; i < 8; ++i) { float acc[8];
#pragma unroll
                for (int c = 0; c < 8; ++c) acc[c] = 0.f;
#pragma unroll
                for (int j = 0; j < 3; ++j)
#pragma unroll
                    for (int q = 0; q < 4; ++q) { acc[2 * q] += bflo(ru[i + j][q]) * bflo(rc[i + j][q]) * wv[2 * q][j]; acc[2 * q + 1] += bfhi(ru[i + j][q]) * bfhi(rc[i + j][q]) * wv[2 * q + 1][j]; }
                v4u o;
#pragma unroll
                for (int q = 0; q < 4; ++q) o[q] = pk2(acc[2 * q] * bflo(rb[i][q]), acc[2 * q + 1] * bfhi(rb[i][q]));
                *(GAS v4u*)(Y + (m0 + i) * DM + 1536 + c0) = o; }
        }
    }
    {
        LAS bf16* tl = (LAS bf16*)(F.lds + RING_OFF + F.wave * 16384);
        GAS bf16* VT = (GAS bf16*)(F.wsb() + WS_VT);
        const int r32 = lane & 31, hi = lane >> 5;
        for (int it = first; it < 2 * NBATCH * NHKV * 64; it += stride) {
            const int tb = it & 63, r1 = it >> 6, hkv = r1 & 1, r2 = r1 >> 1, b = r2 % NBATCH, which = r2 / NBATCH;
            const GAS bf16* src = P + ((size_t)b * SEQ + 32 * tb) * NPROJ + PC_NKV + (3 + 2 * which) * 256 + hkv * 128;
            GAS bf16* dst = VT + ((size_t)((which * NBATCH + b) * NHKV + hkv) * 64 + tb) * 4096;
#pragma unroll
            for (int i = 0; i < 8; ++i) { const int tok = i * 4 + (lane >> 4), ch = lane & 15;
                *(LAS v4u*)(tl + tok * 136 + 8 * ch) = *(const GAS v4u*)(src + (size_t)tok * NPROJ + 8 * ch); }
            LDS_WAIT();
#pragma unroll
            for (int f = 0; f < 8; ++f) { const int db = f >> 1, ks = f & 1; unsigned w[4];
#pragma unroll
                for (int jj = 0; jj < 4; ++jj) { const int j0 = 2 * jj, k0 = 16 * ks + 8 * (j0 >> 2) + 4 * hi + (j0 & 3);
                    w[jj] = (unsigned)tl[k0 * 136 + 32 * db + r32] | ((unsigned)tl[(k0 + 1) * 136 + 32 * db + r32] << 16); }
                v4u o; o.x = w[0]; o.y = w[1]; o.z = w[2]; o.w = w[3];
                *(GAS v4u*)(dst + (f * 64 + lane) * 8) = o; }
            LDS_WAIT();
        }
    }
}

__device__ __forceinline__ void nsa_tables(Frame& F, int l, float& kmax, float& bmax) {
    LAS float* btab2 = (LAS float*)(F.lds + BTAB_OFF);
    for (int i = F.tid(); i < 6 * 132; i += NWAVES * 64) { const int h = i / 132, d = i % 132; btab2[i] = F.inp(I_RELB)[(d < 128 ? (int)T5B[d] : 31) * 6 + h] * LOG2E; }
    for (int i = F.tid(); i < HD; i += NWAVES * 64) ((LAS float*)(F.lds + BTAB_OFF + 3200))[i] = F.inp(I_NQN)[(size_t)l * HD + i];
    const GAS float* kn = F.inp(I_NKN) + (size_t)l * 3 * HD; float km = 0.f, bm = 0.f;
    for (int i = F.lane(); i < 3 * HD; i += 64) km = fmaxf(km, fabsf(kn[i]));
    for (int i = F.lane(); i < 192; i += 64) bm = fmaxf(bm, fabsf(F.inp(I_RELB)[i]));
    kmax = wave_max(km) * 11.313708498984761f; bmax = wave_max(bm);
    __syncthreads();
}
__device__ __forceinline__ void ph_select(Frame& F, int l) {
    float kmax, bmax; nsa_tables(F, l, kmax, bmax);
    const int gw = F.vcu * NWAVES + F.wave, NGW = F.G * NWAVES;
    LAS float* wl = (LAS float*)(F.lds + RING_OFF + F.wave * 16384);
    for (int it = gw; it < NBATCH * GH * 32; it += NGW) gdn_chunk_unit(F, it, wl, (LAS float*)(F.lds + FL_OFF + F.wave * 1024));
    { const int two = NBATCH * GH * 32 - NGW; if (two > 0 && two < NGW) { if (gw >= two) ph_fill(F, l, gw - two, NGW - two); } else ph_fill(F, l, gw, NGW); }
    for (int it = gw; it < NBATCH * NHKV * 64; it += NGW) nsa_select_unit(F, l, it, wl, (const LAS float*)(F.lds + BTAB_OFF), kmax, bmax);
}
__device__ __forceinline__ void ph_mix2(Frame& F, int l) {
    float kmax, bmax; nsa_tables(F, l, kmax, bmax);
    const int bx = (int)blockIdx.x;
    if (bx < 96) gdn_scan_block(F, bx);
    volatile LAS int* tk = (volatile LAS int*)(F.lds + MISC_OFF + 64);
    gu32* qctr = F.ctl + CW_Q + 64 * (8 + l);
    const int home = (bx < 96) ? (255 - bx) : (bx - 96);
#pragma unroll 1
    for (int k = 0;; ++k) {
        int u, g;
        if (k < 2 && bx < 256 && (int)gridDim.x >= 256) { u = home; g = k; }
        else {
            if (F.tid() == 0) tk[0] = (int)__hip_atomic_fetch_add(qctr, 1u, RLX_AGENT);
            __syncthreads();
            const int j = tk[0];
            __syncthreads();
            if ((int)gridDim.x >= 256) { if (j >= 256) break; u = j; g = 2; } else { if (j >= 768) break; u = j / 3; g = j % 3; }
        }
        nsa_attn_block(F, l, u, g, (const LAS float*)(F.lds + BTAB_OFF), kmax, bmax);
    }
}
__device__ __forceinline__ void ph_mix3(Frame& F, int l) {
    const int gw = F.vcu * NWAVES + F.wave, NGW = F.G * NWAVES, lane = F.lane();
    const GAS bf16* P = (const GAS bf16*)(F.wsb() + WS_PROJ); const GAS bf16* GO = (const GAS bf16*)(F.wsb() + WS_GO); GAS bf16* Y = (GAS bf16*)(F.wsb() + WS_H);
    const GAS float* gn = F.inp(I_GNORM) + (size_t)l * HD + 2 * lane;
    for (int it = gw; it < (MTOK / 16) * GH; it += NGW) { const int h = it % GH; const size_t m0 = (size_t)(it / GH) * 16;
        unsigned ow[16], zw[16];
#pragma unroll
        for (int i = 0; i < 16; ++i) { ow[i] = *(const GAS unsigned*)(GO + (m0 + i) * 768 + h * HD + 2 * lane); zw[i] = *(const GAS unsigned*)(P + (m0 + i) * NPROJ + PC_GZ + h * HD + 2 * lane); }
        const float g0 = gn[0], g1 = gn[1];
#pragma unroll
        for (int i = 0; i < 16; ++i) { const float ox = bflo(ow[i]), oy = bfhi(ow[i]);
            const float rs = 1.0f / sqrtf(wave_sum(ox * ox + oy * oy) * (1.f / HD) + RMS_EPS);
            *(GAS unsigned*)(Y + (m0 + i) * DM + h * HD + 2 * lane) = pk2(ox * rs * g0 * pg8::silu_f(bflo(zw[i])), oy * rs * g1 * pg8::silu_f(bfhi(zw[i]))); }
    }
}

struct Args { const GAS float* in[19]; GAS float* out; GAS unsigned char* ws; int l_lo, l_hi, ph_lo, ph_hi; };
__global__ void __launch_bounds__(NWAVES * 64, 2) trunk_fwd(Args args) {
    extern __shared__ __attribute__((aligned(16))) unsigned char lds[];
    Frame F;
    F.lds = (LAS unsigned char*)lds;
    { int w_ = __builtin_amdgcn_readfirstlane((int)threadIdx.x >> 6); asm volatile("" : "+s"(w_)); F.wave = w_; }
    F.G = gridDim.x; { const int bx = blockIdx.x; F.vcu = (F.G % 8 == 0) ? (bx % 8) * (F.G / 8) + bx / 8 : bx; }
    F.kp = (const __attribute__((address_space(4))) unsigned char*)__builtin_amdgcn_kernarg_segment_ptr(); F.ws_ = args.ws; F.ctl = (gu32*)(args.ws + WS_CTL); F.out = args.out;
    for (int u = F.tid(); u < (LDS_BYTES - LDSCTL_OFF) / 4; u += NWAVES * 64) ((LAS unsigned*)(F.lds + LDSCTL_OFF))[u] = 0u;
    __syncthreads();
#if MK_ONE_LAUNCH
    XcdBarrier bar = xcd_barrier_post((GAS unsigned*)(F.ctl + CW_BAR), (volatile LAS unsigned*)(F.lds + MISC_OFF) + 8);
#define GRID_BAR() xcd_barrier(bar, F.tid())
#else
#define GRID_BAR() do {} while (0)
#endif
    GAS bf16* WIN = (GAS bf16*)(F.wsb() + WS_WIN); GAS bf16* WOUT = (GAS bf16*)(F.wsb() + WS_WOUT); GAS bf16* WGU = (GAS bf16*)(F.wsb() + WS_WGU); GAS bf16* WDN = (GAS bf16*)(F.wsb() + WS_WDN);
    GAS bf16* H = (GAS bf16*)(F.wsb() + WS_H); GAS bf16* PROJ = (GAS bf16*)(F.wsb() + WS_PROJ);
    for (int l = args.l_lo; l < args.l_hi; ++l) {
        const GAS float* xin = (l == 0) ? F.inp(I_X) : F.out;
#define IN(k) (args.ph_lo <= (k) && (k) < args.ph_hi)
        if (IN(0)) { ph_convert(F, l); ph_norm(F, xin, F.inp(I_NMIX) + (size_t)l * DM); GRID_BAR(); }
        if (IN(1)) { pg8::Gemm g{H, WIN, MTOK, NPROJ, DM}; pg8::StaticOrder S; S.init(MTOK, NPROJ, F.G, (int)blockIdx.x); pg8::EpiBf16 E{PROJ, NPROJ};
            pg8::gemm_phase<pg8::EpiBf16, pg8::StaticOrder, true, true>(F.lds + RING_OFF, g, S, E, F.wave); GRID_BAR(); }
        if (IN(2)) { ph_mix1(F, l); GRID_BAR(); }
        if (IN(3)) { ph_select(F, l); GRID_BAR(); }
        if (IN(4)) { ph_mix2(F, l); GRID_BAR(); }
        if (IN(5)) { ph_mix3(F, l); GRID_BAR(); }
        if (IN(6)) { pg8::Gemm g{H, WOUT, MTOK, DM, DM}; pg8::StaticOrder S; S.init(MTOK, DM, F.G, (int)blockIdx.x); pg8::EpiResF32 E{xin, F.out, DM};
            pg8::gemm_phase<pg8::EpiResF32, pg8::StaticOrder, true, true>(F.lds + RING_OFF, g, S, E, F.wave); GRID_BAR(); }
        if (IN(7)) { ph_norm(F, F.out, F.inp(I_NFFN) + (size_t)l * DM); GRID_BAR(); }
        if (IN(8)) { pg8::Gemm g{H, WGU, MTOK, NGU, DM}; pg8::StaticOrder S; S.init(MTOK, NGU, F.G, (int)blockIdx.x); pg8::EpiSwiGLU E{PROJ, DFF};
            pg8::gemm_phase<pg8::EpiSwiGLU, pg8::StaticOrder, true, true>(F.lds + RING_OFF, g, S, E, F.wave); GRID_BAR(); }
        if (IN(9)) { pg8::Gemm g{PROJ, WDN, MTOK, DM, DFF}; pg8::StaticOrder S; S.init(MTOK, DM, F.G, (int)blockIdx.x); pg8::EpiResF32 E{F.out, F.out, DM};
            pg8::gemm_phase<pg8::EpiResF32, pg8::StaticOrder, true, true>(F.lds + RING_OFF, g, S, E, F.wave); if (l + 1 < args.l_hi) GRID_BAR(); }
#undef IN
    }
}

extern "C" void kernel_launch(void* const* d_in, const int* in_sizes, int n_in, void* d_out, int out_size, void* d_ws, size_t ws_size, hipStream_t stream) {
    static int grid = 0;
    if (grid == 0) {
        if (n_in != 19 || in_sizes[0] != MTOK * DM || out_size != MTOK * DM || ws_size < WS_END) { fprintf(stderr, "kernel_launch: unexpected shapes (n_in %d, in0 %d, out %d, ws %zu); nothing launched\n", n_in, n_in > 0 ? in_sizes[0] : -1, out_size, ws_size); grid = -1; return; }
        int dev = 0, cus = 0;
        if (hipGetDevice(&dev) != hipSuccess || hipDeviceGetAttribute(&cus, hipDeviceAttributeMultiprocessorCount, dev) != hipSuccess) { grid = -1; return; }
        if (hipFuncSetAttribute((const void*)trunk_fwd, hipFuncAttributeMaxDynamicSharedMemorySize, LDS_BYTES) != hipSuccess) { fprintf(stderr, "kernel_launch: hipFuncSetAttribute failed\n"); grid = -1; return; }
        int per_cu = 0;
        if (hipOccupancyMaxActiveBlocksPerMultiprocessor(&per_cu, (const void*)trunk_fwd, NWAVES * 64, LDS_BYTES) != hipSuccess || per_cu < 1) fprintf(stderr, "kernel_launch: occupancy query reports %d\n", per_cu);
        (void)hipGetLastError();
        grid = cus;
    }
    if (grid < 0) return;
    if (hipMemsetAsync((char*)d_ws + WS_CTL, 0, CTL_ZERO_BYTES, stream) != hipSuccess) return;
    Args a{};
    for (int i = 0; i < 19; ++i) a.in[i] = (const GAS float*)d_in[i];
    a.out = (GAS float*)d_out; a.ws = (GAS unsigned char*)d_ws;
#if MK_ONE_LAUNCH
    a.l_lo = 0; a.l_hi = DEPTH; a.ph_lo = 0; a.ph_hi = NPHASE;
    hipLaunchKernelGGL(trunk_fwd, dim3(grid), dim3(NWAVES * 64), LDS_BYTES, stream, a);
#else
    for (int l = 0; l < DEPTH; ++l)
        for (int ph = 0; ph < NPHASE; ++ph) { a.l_lo = l; a.l_hi = l + 1; a.ph_lo = ph; a.ph_hi = ph + 1;
            hipLaunchKernelGGL(trunk_fwd, dim3(grid), dim3(NWAVES * 64), LDS_BYTES, stream, a); }
#endif
}
```

```cpp
#include <hip/hip_runtime.h>
#include <cstdio>
#include <cstdint>
#define GAS __attribute__((address_space(1)))

#ifndef MK_ONE_LAUNCH
#define MK_ONE_LAUNCH 1
#endif

namespace pg8 {
#define PG8_LAS __attribute__((address_space(3)))
typedef unsigned short bf16_t;
typedef short bf16x8 __attribute__((ext_vector_type(8)));
typedef float f32x4 __attribute__((ext_vector_type(4)));
typedef unsigned u32x4 __attribute__((ext_vector_type(4)));
constexpr int BM = 256, BK = 64, HALF = 128, HTB = HALF * BK * 2, STAGE_BYTES = 8 * HTB, NXCD = 8, WGM = 4;

__host__ __device__ __forceinline__ int lds_byte(int r, int c) { const int st = (r >> 4) * 2 + (c >> 5), rr = r & 15, cc = c & 31, ob = rr * 64 + cc * 2; return st * 1024 + (ob ^ (((ob >> 9) & 1) << 5)); }
__host__ __device__ __forceinline__ void stage_rc(int b, int& R, int& C) { const int st = b / 1024, sb = b % 1024, swz = sb ^ (((sb >> 9) & 1) << 5); R = (st >> 1) * 16 + swz / 64; C = (st & 1) * 32 + (swz % 64) / 2; }
__host__ __device__ __forceinline__ int perm32(int rho) { const int n = rho >> 4, i = rho & 15; return 8 * (i >> 2) + 4 * n + (i & 3); }

struct Unit { int pm, pn; };
struct Gemm { const GAS bf16_t* A; const GAS bf16_t* Bt; int M, N, K; };

struct StaticOrder {
    int nM, nN, nwg, G, c;
    __host__ __device__ void init(int M, int N, int G_, int c_) { nM = M / BM; nN = N / BM; nwg = nM * nN; G = G_; c = c_; }
    __host__ __device__ bool next(int i, Unit& u) const {
        const long L = (long)i * G + c; if (L >= nwg) return false;
        int wgid = (int)L; { const int q = nwg / NXCD, r = nwg % NXCD, xcd = wgid % NXCD, off = wgid / NXCD; wgid = (xcd < r ? xcd * (q + 1) : r * (q + 1) + (xcd - r) * q) + off; }
        const int nig = WGM * nN, gid = wgid / nig, fm = gid * WGM, gsz = (nM - fm) < WGM ? (nM - fm) : WGM;
        u.pm = fm + ((wgid % nig) % gsz); u.pn = (wgid % nig) / gsz; return true;
    }
    __device__ __forceinline__ void a_ready(const Unit&) const {}
    __device__ __forceinline__ void done(const Unit&) const {}
};

__device__ __forceinline__ unsigned cvt_pk_bf16(float lo, float hi) { unsigned r; asm volatile("v_cvt_pk_bf16_f32 %0, %1, %2" : "=v"(r) : "v"(lo), "v"(hi)); return r; }

struct EpiBf16 {
    static constexpr bool PERM = true, AFTER_DRAIN = false;
    GAS bf16_t* O; int ldc;
    __device__ __forceinline__ void operator()(const f32x4 (&acc)[2][2][4][2], const Unit& u, int wr, int wc, int fr, int fq) const {
        const int row0 = u.pm * BM + wr * 64 + fr; const int col0 = u.pn * BM + wc * 32 + 8 * fq;
#pragma unroll
        for (int ai = 0; ai < 2; ++ai)
#pragma unroll
            for (int m = 0; m < 4; ++m) { GAS bf16_t* rowp = O + (size_t)(row0 + ai * HALF + m * 16) * ldc + col0;
#pragma unroll
                for (int bj = 0; bj < 2; ++bj) { const f32x4 v0 = acc[ai][bj][m][0], v1 = acc[ai][bj][m][1];
                    u32x4 w; w.x = cvt_pk_bf16(v0[0], v0[1]); w.y = cvt_pk_bf16(v0[2], v0[3]); w.z = cvt_pk_bf16(v1[0], v1[1]); w.w = cvt_pk_bf16(v1[2], v1[3]);
                    *(GAS u32x4*)(rowp + bj * HALF) = w; } }
    }
};
struct EpiResF32 {
    static constexpr bool PERM = false, AFTER_DRAIN = false;
    const GAS float* base; GAS float* out; int ldc;
    __device__ __forceinline__ void operator()(const f32x4 (&acc)[2][2][4][2], const Unit& u, int wr, int wc, int fr, int fq) const {
        const int row0 = u.pm * BM + wr * 64 + fr, col0 = u.pn * BM + wc * 32 + 4 * fq;
#pragma unroll
        for (int ai = 0; ai < 2; ++ai)
#pragma unroll
            for (int m = 0; m < 4; ++m) { const size_t off = (size_t)(row0 + ai * HALF + m * 16) * ldc + col0;
#pragma unroll
                for (int bj = 0; bj < 2; ++bj)
#pragma unroll
                    for (int n = 0; n < 2; ++n) { const f32x4 b = *(const GAS f32x4*)(base + off + bj * HALF + n * 16); *(GAS f32x4*)(out + off + bj * HALF + n * 16) = b + acc[ai][bj][m][n]; } }
    }
};
__device__ __forceinline__ float silu_f(float x) { return x * __builtin_amdgcn_rcpf(1.0f + __expf(-x)); }
struct EpiSwiGLU {
    static constexpr bool PERM = true, AFTER_DRAIN = false;
    GAS bf16_t* O; int ldc;
    __device__ __forceinline__ void operator()(const f32x4 (&acc)[2][2][4][2], const Unit& u, int wr, int wc, int fr, int fq) const {
        const int row0 = u.pm * BM + wr * 64 + fr; const int col0 = u.pn * HALF + wc * 32 + 8 * fq;
#pragma unroll
        for (int ai = 0; ai < 2; ++ai)
#pragma unroll
            for (int m = 0; m < 4; ++m) { GAS bf16_t* rowp = O + (size_t)(row0 + ai * HALF + m * 16) * ldc + col0;
                const f32x4 g0 = acc[ai][0][m][0], g1 = acc[ai][0][m][1], u0 = acc[ai][1][m][0], u1 = acc[ai][1][m][1];
                float r[8];
#pragma unroll
                for (int j = 0; j < 4; ++j) { r[j] = silu_f(g0[j]) * u0[j]; r[4 + j] = silu_f(g1[j]) * u1[j]; }
                u32x4 w; w.x = cvt_pk_bf16(r[0], r[1]); w.y = cvt_pk_bf16(r[2], r[3]); w.z = cvt_pk_bf16(r[4], r[5]); w.w = cvt_pk_bf16(r[6], r[7]);
                *(GAS u32x4*)rowp = w; }
    }
};

template <class Epi, class Sched, bool ALIGN_EPI = false, bool SP2 = false>
__device__ __forceinline__ void gemm_phase(PG8_LAS unsigned char* lds, const Gemm g, const Sched& S, const Epi& E, int wave_id) {
    int tid_; asm volatile("v_mbcnt_lo_u32_b32 %0, -1, 0\n\tv_mbcnt_hi_u32_b32 %0, -1, %0" : "=v"(tid_)); tid_ += wave_id * 64;
    const int tid = tid_, wid = __builtin_amdgcn_readfirstlane(tid >> 6), lane = tid & 63, wr = wid >> 2, wc = wid & 3, fr = lane & 15, fq = lane >> 4;
    const int K = g.K, nt = K / BK;
    unsigned voffA[2], voffB[2];
#pragma unroll
    for (int i = 0; i < 2; ++i) { int R, C; stage_rc(tid * 16 + i * 8192, R, C); const int Rb = Epi::PERM ? ((R & ~31) + perm32(R & 31)) : R;
        voffA[i] = (unsigned)(R * K + C) * 2u; voffB[i] = (unsigned)(Rb * K + C) * 2u; }
    const size_t kstep = (size_t)(BK * 2);
    const size_t hstep = (size_t)HALF * K * 2;
    const size_t tstep = 2 * hstep;
    const unsigned ldsw = (unsigned)wid * 1024u;
    const int aoff = lds_byte(wr * 64 + fr, fq * 8), boff = lds_byte(wc * 32 + fr, fq * 8);
#define PG8_SA(b, h) (((b) * 2 + (h)) * HTB)
#define PG8_SB(b, h) ((4 + (b) * 2 + (h)) * HTB)
#define PG8_STAGE(bufoff, gbase, voff) do { _Pragma("unroll") for (int _i = 0; _i < 2; ++_i) \
        __builtin_amdgcn_global_load_lds((const GAS unsigned*)((const GAS char*)(gbase) + (voff)[_i]), (PG8_LAS unsigned*)(lds + (bufoff) + ldsw + _i * 8192), 16, 0, 0); } while (0)
#define PG8_LDA(dst, b, h) do { _Pragma("unroll") for (int m = 0; m < 4; ++m) _Pragma("unroll") for (int k = 0; k < 2; ++k) dst[m][k] = *(const PG8_LAS bf16x8*)(lds + PG8_SA(b, h) + aoff + m * 2048 + k * 1024); } while (0)
#define PG8_LDB(dst, b, h) do { _Pragma("unroll") for (int n = 0; n < 2; ++n) _Pragma("unroll") for (int k = 0; k < 2; ++k) dst[n][k] = *(const PG8_LAS bf16x8*)(lds + PG8_SB(b, h) + boff + n * 2048 + k * 1024); } while (0)
#define PG8_MMA(ai, bj, At, Bt) do { __builtin_amdgcn_s_setprio(1); _Pragma("unroll") for (int m = 0; m < 4; ++m) _Pragma("unroll") for (int n = 0; n < 2; ++n) _Pragma("unroll") for (int k = 0; k < 2; ++k) \
        acc[ai][bj][m][n] = __builtin_amdgcn_mfma_f32_16x16x32_bf16(Bt[n][k], At[m][k], acc[ai][bj][m][n], 0, 0, 0); __builtin_amdgcn_s_setprio(0); } while (0)
#define PG8_WAIT_V(n) asm volatile("s_waitcnt vmcnt(" #n ")" ::: "memory")
#define PG8_WAIT_L(n) asm volatile("s_waitcnt lgkmcnt(" #n ")" ::: "memory")
#define PG8_BAR __builtin_amdgcn_s_barrier()
#define PG8_SCHED __builtin_amdgcn_sched_barrier(0)
    Unit cur, nxt; int ui = 0;
    if (!S.next(0, cur)) return;
    f32x4 acc[2][2][4][2];
#pragma unroll
    for (int a = 0; a < 2; ++a)
#pragma unroll
        for (int b = 0; b < 2; ++b)
#pragma unroll
            for (int m = 0; m < 4; ++m)
#pragma unroll
                for (int n = 0; n < 2; ++n) acc[a][b][m][n] = (f32x4){0.f, 0.f, 0.f, 0.f};
    bf16x8 At[4][2], B0[2][2], B1[2][2];
    const GAS char* cA = (const GAS char*)g.A + (size_t)cur.pm * tstep; const GAS char* cB = (const GAS char*)g.Bt + (size_t)cur.pn * tstep;
    S.a_ready(cur);
    if constexpr (SP2) {
        PG8_STAGE(PG8_SB(0, 0), cB, voffB); PG8_STAGE(PG8_SB(0, 1), cB + hstep, voffB); PG8_STAGE(PG8_SA(0, 0), cA, voffA); PG8_STAGE(PG8_SA(0, 1), cA + hstep, voffA);
        if (wr == 1) PG8_BAR;
        PG8_WAIT_V(2); PG8_BAR;
        PG8_STAGE(PG8_SB(1, 0), cB + kstep, voffB); PG8_STAGE(PG8_SA(1, 0), cA + kstep, voffA); PG8_STAGE(PG8_SB(1, 1), cB + hstep + kstep, voffB);
        PG8_WAIT_V(6); PG8_BAR;
    } else {
        PG8_STAGE(PG8_SB(0, 0), cB, voffB); PG8_STAGE(PG8_SA(0, 0), cA, voffA); PG8_STAGE(PG8_SB(0, 1), cB + hstep, voffB); PG8_STAGE(PG8_SA(0, 1), cA + hstep, voffA);
        if (wr == 1) PG8_BAR;
        PG8_WAIT_V(4); PG8_BAR;
        PG8_STAGE(PG8_SB(1, 0), cB + kstep, voffB); PG8_STAGE(PG8_SA(1, 0), cA + kstep, voffA); PG8_STAGE(PG8_SB(1, 1), cB + hstep + kstep, voffB);
        PG8_WAIT_V(6); PG8_BAR;
    }
    for (;;) {
        const bool has_next = S.next(ui + 1, nxt);
        const GAS char* nA = has_next ? (const GAS char*)g.A + (size_t)nxt.pm * tstep : cA; const GAS char* nB = has_next ? (const GAS char*)g.Bt + (size_t)nxt.pn * tstep : cB;
        for (int t = 0; t < nt; t += 2) {
            const bool last = (t == nt - 2);
            const GAS char* a1 = cA + (size_t)(t + 1) * kstep;
            const GAS char* a2 = last ? nA : cA + (size_t)(t + 2) * kstep; const GAS char* b2 = last ? nB : cB + (size_t)(t + 2) * kstep;
            const GAS char* a3 = a2 + kstep; const GAS char* b3 = b2 + kstep;
            if (last && has_next) S.a_ready(nxt);
            if constexpr (SP2) {
            PG8_LDB(B0, 0, 0); PG8_LDB(B1, 0, 1); PG8_SCHED; PG8_LDA(At, 0, 0); PG8_STAGE(PG8_SA(1, 1), a1 + hstep, voffA);
            PG8_WAIT_V(8); PG8_WAIT_L(0); PG8_BAR; PG8_MMA(0, 0, At, B0); PG8_MMA(0, 1, At, B1); PG8_BAR; PG8_SCHED;
            PG8_LDA(At, 0, 1); PG8_STAGE(PG8_SB(0, 0), b2, voffB); PG8_STAGE(PG8_SB(0, 1), b2 + hstep, voffB); PG8_STAGE(PG8_SA(0, 0), a2, voffA);
            PG8_WAIT_V(8); PG8_WAIT_L(0); PG8_BAR; PG8_MMA(1, 0, At, B0); PG8_MMA(1, 1, At, B1); PG8_BAR; PG8_SCHED;
            PG8_LDB(B0, 1, 0); PG8_LDB(B1, 1, 1); PG8_SCHED; PG8_LDA(At, 1, 0); PG8_STAGE(PG8_SA(0, 1), a2 + hstep, voffA);
            PG8_WAIT_V(8); PG8_WAIT_L(0); PG8_BAR; PG8_MMA(0, 0, At, B0); PG8_MMA(0, 1, At, B1); PG8_BAR; PG8_SCHED;
            PG8_LDA(At, 1, 1); PG8_STAGE(PG8_SB(1, 0), b3, voffB); PG8_STAGE(PG8_SB(1, 1), b3 + hstep, voffB); PG8_STAGE(PG8_SA(1, 0), a3, voffA);
            PG8_WAIT_V(8); PG8_WAIT_L(0); PG8_BAR; PG8_MMA(1, 0, At, B0); PG8_MMA(1, 1, At, B1); PG8_BAR; PG8_SCHED;
            } else {
            PG8_LDB(B0, 0, 0); PG8_SCHED; PG8_LDA(At, 0, 0); PG8_STAGE(PG8_SA(1, 1), a1 + hstep, voffA);
            PG8_WAIT_L(8); PG8_BAR; PG8_WAIT_L(0); PG8_MMA(0, 0, At, B0); PG8_BAR; PG8_SCHED;
            PG8_LDB(B1, 0, 1); PG8_STAGE(PG8_SB(0, 0), b2, voffB);
            PG8_BAR; PG8_WAIT_L(0); PG8_MMA(0, 1, At, B1); PG8_BAR;
            PG8_LDA(At, 0, 1); PG8_STAGE(PG8_SA(0, 0), a2, voffA);
            PG8_BAR; PG8_WAIT_L(0); PG8_MMA(1, 0, At, B0); PG8_BAR; PG8_SCHED;
            PG8_STAGE(PG8_SB(0, 1), b2 + hstep, voffB);
            PG8_WAIT_V(6); PG8_BAR; PG8_MMA(1, 1, At, B1); PG8_BAR;
            PG8_LDB(B0, 1, 0); PG8_SCHED; PG8_LDA(At, 1, 0); PG8_STAGE(PG8_SA(0, 1), a2 + hstep, voffA);
            PG8_WAIT_L(8); PG8_BAR; PG8_WAIT_L(0); PG8_MMA(0, 0, At, B0); PG8_BAR; PG8_SCHED;
            PG8_LDB(B1, 1, 1); PG8_STAGE(PG8_SB(1, 0), b3, voffB);
            PG8_BAR; PG8_WAIT_L(0); PG8_MMA(0, 1, At, B1); PG8_BAR;
            PG8_LDA(At, 1, 1); PG8_STAGE(PG8_SA(1, 0), a3, voffA);
            PG8_BAR; PG8_WAIT_L(0); PG8_MMA(1, 0, At, B0); PG8_BAR; PG8_SCHED;
            PG8_STAGE(PG8_SB(1, 1), b3 + hstep, voffB);
            PG8_WAIT_V(6); PG8_BAR; PG8_MMA(1, 1, At, B1); PG8_BAR;
            }
        }
        if constexpr (ALIGN_EPI) { if (wr == 0) PG8_BAR; }
        if constexpr (!Epi::AFTER_DRAIN) { E(acc, cur, wr, wc, fr, fq); S.done(cur); }
        if (!has_next) break;
#pragma unroll
        for (int a = 0; a < 2; ++a)
#pragma unroll
            for (int b = 0; b < 2; ++b)
#pragma unroll
                for (int m = 0; m < 4; ++m)
#pragma unroll
                    for (int n = 0; n < 2; ++n) acc[a][b][m][n] = (f32x4){0.f, 0.f, 0.f, 0.f};
        cur = nxt; cA = nA; cB = nB; ++ui;
        if constexpr (ALIGN_EPI) { if (wr == 1) PG8_BAR; }
    }
    PG8_WAIT_V(0);
    if constexpr (!ALIGN_EPI) { if (wr == 0) PG8_BAR; }
    PG8_BAR;
#undef PG8_SA
#undef PG8_SB
#undef PG8_STAGE
#undef PG8_LDA
#undef PG8_LDB
#undef PG8_MMA
#undef PG8_WAIT_V
#undef PG8_WAIT_L
#undef PG8_BAR
#undef PG8_SCHED
}
}

constexpr int NWAVES = 8;
constexpr int DM = 2048, NBATCH = 16, SEQ = 2048, MTOK = NBATCH * SEQ, DEPTH = 4;
constexpr int NPROJ = 7168, PROJ_ORIG = 6942, DFF = 5632, NGU = 2 * DFF;
constexpr int GH = 6, HD = 128, NHKV = 2, NCMP = 127;
constexpr int PC_GQKV = 0, PC_GZ = 2304, PC_NQ = 3072, PC_NKV = 3840, PC_CU = 5376, PC_CB = 5888, PC_CC = 6400, PC_GB = 6912, PC_GA = 6918, PC_NG = 6924;
constexpr float RMS_EPS = 1e-6f;
constexpr int NPHASE = 10;

constexpr size_t MiB = 1u << 20;
constexpr size_t WS_CTL = 0, CTL_ZERO_BYTES = 1 * MiB;
constexpr size_t WS_WIN = 2 * MiB, WS_WOUT = 30 * MiB, WS_WGU = 38 * MiB, WS_WDN = 82 * MiB;
constexpr size_t WS_H = 104 * MiB;
constexpr size_t WS_PROJ = 232 * MiB;
constexpr size_t WS_GQ = 680 * MiB, WS_GK = 728 * MiB, WS_GV = 776 * MiB;
constexpr size_t WS_GO = 824 * MiB;
constexpr size_t WS_GU = 872 * MiB;
constexpr size_t WS_ATT = 994 * MiB;
constexpr size_t WS_EGL = 1018 * MiB;
constexpr size_t WS_KN = 920 * MiB;
constexpr size_t WS_KCB = 952 * MiB;
constexpr size_t WS_VCT = 953 * MiB;
constexpr size_t WS_GBG = 956 * MiB;
constexpr size_t WS_VT = 958 * MiB;
constexpr size_t WS_W1T = 990 * MiB;
constexpr size_t WS_W2T = 992 * MiB;
constexpr size_t WS_CBP = 992 * MiB + 131072;
constexpr size_t WS_SEL = 993 * MiB;
constexpr size_t WS_END = 1019 * MiB;
constexpr int CW_TMO = 0, CW_BAR = 4096, CW_Q = 16384;

constexpr int RING_OFF = 0, RING_BYTES = 131072;
constexpr int LDSCTL_OFF = RING_BYTES, MISC_OFF = LDSCTL_OFF + 320, BTAB_OFF = LDSCTL_OFF + 1024, FL_OFF = LDSCTL_OFF + 8192;
constexpr int LDS_BYTES = 147456;

#define LAS __attribute__((address_space(3)))
typedef unsigned short bf16;
typedef unsigned v4u __attribute__((ext_vector_type(4)));
typedef unsigned v2u __attribute__((ext_vector_type(2)));
typedef float f32x4 __attribute__((ext_vector_type(4)));
typedef GAS unsigned gu32;
#define RLX_AGENT __ATOMIC_RELAXED, __HIP_MEMORY_SCOPE_AGENT
#define LDS_WAIT() asm volatile("s_waitcnt lgkmcnt(0)" ::: "memory")
__device__ __forceinline__ unsigned f2bf(float f) { unsigned u = __builtin_bit_cast(unsigned, f); return (u + 0x7fffu + ((u >> 16) & 1u)) >> 16; }
__device__ __forceinline__ unsigned pk2(float lo, float hi) { return f2bf(lo) | (f2bf(hi) << 16); }
__device__ __forceinline__ float bflo(unsigned w) { return __uint_as_float(w << 16); }
__device__ __forceinline__ float bfhi(unsigned w) { return __uint_as_float(w & 0xffff0000u); }
__device__ __forceinline__ float bf2f(bf16 b) { return __uint_as_float(((unsigned)b) << 16); }
__device__ __forceinline__ float xl1(float v) { return __int_as_float(__builtin_amdgcn_update_dpp(0, __float_as_int(v), 0xB1, 0xf, 0xf, false)); }
__device__ __forceinline__ float xl2(float v) { return __int_as_float(__builtin_amdgcn_update_dpp(0, __float_as_int(v), 0x4E, 0xf, 0xf, false)); }
__device__ __forceinline__ float xl7(float v) { return __int_as_float(__builtin_amdgcn_update_dpp(0, __float_as_int(v), 0x141, 0xf, 0xf, false)); }
__device__ __forceinline__ float xl15(float v) { return __int_as_float(__builtin_amdgcn_update_dpp(0, __float_as_int(v), 0x140, 0xf, 0xf, false)); }
__device__ __forceinline__ float xl16(float v) { return __int_as_float(__builtin_amdgcn_ds_swizzle(__float_as_int(v), 0x401F)); }
__device__ __forceinline__ float sum32(float v) { auto r = __builtin_amdgcn_permlane32_swap(__float_as_uint(v), __float_as_uint(v), false, false); return __uint_as_float(r[0]) + __uint_as_float(r[1]); }
__device__ __forceinline__ float max32(float v) { auto r = __builtin_amdgcn_permlane32_swap(__float_as_uint(v), __float_as_uint(v), false, false); return fmaxf(__uint_as_float(r[0]), __uint_as_float(r[1])); }
__device__ __forceinline__ unsigned or32(unsigned v) { auto r = __builtin_amdgcn_permlane32_swap(v, v, false, false); return r[0] | r[1]; }
__device__ __forceinline__ float wave_sum(float v) { v += xl1(v); v += xl2(v); v += xl7(v); v += xl15(v); v += xl16(v); return sum32(v); }
__device__ __forceinline__ float wave_max(float v) { v = fmaxf(v, xl1(v)); v = fmaxf(v, xl2(v)); v = fmaxf(v, xl7(v)); v = fmaxf(v, xl15(v)); v = fmaxf(v, xl16(v)); return max32(v); }
__device__ __forceinline__ unsigned wave_or(unsigned v) { v |= __float_as_uint(xl1(__uint_as_float(v))); v |= __float_as_uint(xl2(__uint_as_float(v))); v |= __float_as_uint(xl7(__uint_as_float(v))); v |= __float_as_uint(xl15(__uint_as_float(v))); v |= __float_as_uint(xl16(__uint_as_float(v))); return or32(v); }
__device__ __forceinline__ int lane_id() { return (int)__builtin_amdgcn_mbcnt_hi(~0u, __builtin_amdgcn_mbcnt_lo(~0u, 0u)); }
__device__ __forceinline__ float sigmoid_f(float x) { return 1.0f / (1.0f + __expf(-x)); }
__device__ __forceinline__ float rl(float v, int l) { return __int_as_float(__builtin_amdgcn_readlane(__float_as_int(v), l)); }

__constant__ unsigned char T5B[128] = {0, 1, 2, 3, 4, 5, 6, 7, 8, 9, 10, 11, 12, 13, 14, 15, 16, 16, 16, 17, 17, 18, 18, 18, 19, 19, 19, 20, 20, 20, 20, 21, 21, 21, 21, 22, 22, 22, 22, 22, 23, 23, 23, 23, 23, 23, 24, 24, 24, 24, 24, 24, 25, 25, 25, 25, 25, 25, 25, 26, 26, 26, 26, 26, 26, 26, 26, 27, 27, 27, 27, 27, 27, 27, 27, 27, 27, 28, 28, 28, 28, 28, 28, 28, 28, 28, 28, 29, 29, 29, 29, 29, 29, 29, 29, 29, 29, 29, 29, 30, 30, 30, 30, 30, 30, 30, 30, 30, 30, 30, 30, 30, 30, 31, 31, 31, 31, 31, 31, 31, 31, 31, 31, 31, 31, 31, 31, 31};

#define XB_TMO      128
#define XB_XCNT(j)  (256  + 64 * (j))
#define XB_XSUB(j)  (1280 + 64 * (j))
#define XB_XGEN(j)  (2304 + 64 * (j))
#define XB_TOP      3328
#define XB_TOPGEN   3392
#define XCD_BAR_WORDS 3456
#define XB_SPIN_CAP (1u << 22)
__device__ __forceinline__ unsigned xb_ld(GAS unsigned* p)              { return __hip_atomic_load(p, __ATOMIC_RELAXED, __HIP_MEMORY_SCOPE_AGENT); }
__device__ __forceinline__ unsigned xb_add(GAS unsigned* p, unsigned v) { return __hip_atomic_fetch_add(p, v, __ATOMIC_RELAXED, __HIP_MEMORY_SCOPE_AGENT); }
__device__ __forceinline__ unsigned xb_xcc_id() { return (unsigned)__builtin_amdgcn_s_getreg((3 << 11) | 20) & 0xFu; }
#define XB_SPIN(cond, bar) do { unsigned _sp = 0; while (cond) { __builtin_amdgcn_s_sleep(1); \
    if ((++_sp & 255u) == 0u) { if (xb_ld(&(bar)[XB_TMO])) break; if (_sp > XB_SPIN_CAP) { (void)xb_add(&(bar)[XB_TMO], 1u); break; } } } } while (0)
struct XcdBarrier { GAS unsigned* bar; unsigned x; volatile LAS unsigned* st; };
__device__ __forceinline__ XcdBarrier xcd_barrier_post(GAS unsigned* bar, volatile LAS unsigned* st) {
    XcdBarrier b; b.bar = bar; b.x = xb_xcc_id(); b.st = st;
    if (threadIdx.x == 0) (void)xb_add(&bar[XB_XCNT(b.x)], 1u);
    return b;
}
__device__ __forceinline__ void xcd_barrier_complete(GAS unsigned* bar, unsigned x, unsigned& nloc, unsigned& nx) {
    const unsigned G = gridDim.x * gridDim.y * gridDim.z;
    unsigned sum, cnt, mine, sp = 0u;
    for (;;) {
        sum = 0u; cnt = 0u; mine = 0u;
#pragma unroll
        for (unsigned j = 0; j < 16; ++j) { const unsigned c = xb_ld(&bar[XB_XCNT(j)]); sum += c; cnt += (c > 0u) ? 1u : 0u; mine = (j == x) ? c : mine; }
        if (sum == G) break;
        __builtin_amdgcn_s_sleep(1);
        if ((++sp & 255u) == 0u) { if (xb_ld(&bar[XB_TMO])) break; if (sp > XB_SPIN_CAP) { (void)xb_add(&bar[XB_TMO], 1u); break; } }
    }
    nloc = mine > 0u ? mine : 1u; nx = cnt > 0u ? cnt : 1u;
}
__device__ __forceinline__ void xcd_barrier(const XcdBarrier& b, int tid) {
    asm volatile("s_waitcnt vmcnt(0)" ::: "memory");
    __syncthreads();
    if (tid == 0) {
        GAS unsigned* bar = b.bar;
        __builtin_amdgcn_s_waitcnt(0);
        unsigned nloc = b.st[0], nx = b.st[1];
        if (nloc == 0u) { xcd_barrier_complete(bar, b.x, nloc, nx); b.st[0] = nloc; b.st[1] = nx; }
        const unsigned old = xb_add(&bar[XB_XSUB(b.x)], 1u);
        const unsigned gen = old / nloc;
        if (old + 1u == (gen + 1u) * nloc) {
            __builtin_amdgcn_fence(__ATOMIC_RELEASE, "agent");
            asm volatile("s_waitcnt vmcnt(0)" ::: "memory");
            const unsigned og = xb_add(&bar[XB_TOP], 1u);
            const unsigned tg = og / nx;
            if (og + 1u == (tg + 1u) * nx) xb_add(&bar[XB_TOPGEN], 1u);
            else XB_SPIN(xb_ld(&bar[XB_TOPGEN]) == tg, bar);
            __builtin_amdgcn_fence(__ATOMIC_ACQUIRE, "agent");
            xb_add(&bar[XB_XGEN(b.x)], 1u);
            asm volatile("s_waitcnt vmcnt(0)" ::: "memory");
        } else {
            XB_SPIN(xb_ld(&bar[XB_XGEN(b.x)]) == gen, bar);
            __builtin_amdgcn_fence(__ATOMIC_ACQUIRE, "agent");
            asm volatile("s_waitcnt vmcnt(0)" ::: "memory");
        }
    }
    __syncthreads();
}

struct Frame {
    LAS unsigned char* lds;
    gu32* ctl;
    int wave, vcu, G;
    __device__ __forceinline__ int lane() const { int l; asm volatile("v_mbcnt_lo_u32_b32 %0, -1, 0\n\tv_mbcnt_hi_u32_b32 %0, -1, %0" : "=v"(l)); return l; }
    __device__ __forceinline__ int tid() const { return wave * 64 + lane(); }
    const __attribute__((address_space(4))) unsigned char* kp;
    GAS float* out; GAS unsigned char* ws_;
    __device__ __forceinline__ GAS unsigned char* wsb() const { GAS unsigned char* p = ws_; asm volatile("" : "+s"(p)); return p; }
    __device__ __forceinline__ const GAS float* inp(int i) const { const __attribute__((address_space(4))) unsigned char* p = kp; asm volatile("" : "+s"(p)); return ((const GAS float* const __attribute__((address_space(4)))*)p)[i]; }
};
enum { I_X = 0, I_RELB, I_NMIX, I_WIN, I_GCONV, I_GALOG, I_GDT, I_GNORM, I_NQN, I_NKN, I_CPOS, I_CW1, I_CW2, I_SCW, I_WOUT, I_NFFN, I_WG, I_WU, I_WD };

__device__ __forceinline__ void transpose_tile(const GAS float* W, int ldw, int scol, GAS bf16* WTrow0, int K, int k0, LAS float* scr, int lane) {
    float tv[32];
#pragma unroll
    for (int i = 0; i < 32; ++i) { const int kk = 2 * i + (lane >> 5); tv[i] = scol >= 0 ? W[(size_t)(k0 + kk) * ldw + scol] : 0.f; }
#pragma unroll
    for (int i = 0; i < 32; ++i) { const int kk = 2 * i + (lane >> 5); scr[kk * 33 + (lane & 31)] = tv[i]; }
    LDS_WAIT();
    const int c = lane & 7;
#pragma unroll
    for (int j = 0; j < 4; ++j) { const int n = (lane >> 3) + 8 * j; const LAS float* s = scr + (8 * c) * 33 + n;
        v4u o; o.x = pk2(s[0 * 33], s[1 * 33]); o.y = pk2(s[2 * 33], s[3 * 33]); o.z = pk2(s[4 * 33], s[5 * 33]); o.w = pk2(s[6 * 33], s[7 * 33]);
        *(GAS v4u*)(WTrow0 + (size_t)n * K + k0 + 8 * c) = o; }
    LDS_WAIT();
}
__device__ __forceinline__ int win_src(int n) {
    if (n < 3072) return n;
    if (n < 5376) return n + 12;
    if (n < 6912) return n + 30;
    if (n < 6924) return n - 6912 + 3072;
    if (n < 6942) return n - 6924 + 5388;
    return -1;
}
__device__ __forceinline__ void ph_convert(Frame& F, int l) {
    LAS float* scr = (LAS float*)(F.lds + RING_OFF + F.wave * 16384);
    const int gw = F.vcu * NWAVES + F.wave, NGW = F.G * NWAVES, lane = F.lane();
    constexpr int I_A = 32 * (NPROJ / 32), I_B = 32 * (DM / 32), I_C = 32 * (NGU / 32), I_D = (DFF / 64) * (DM / 32);
    GAS bf16* WIN = (GAS bf16*)(F.wsb() + WS_WIN); GAS bf16* WOUT = (GAS bf16*)(F.wsb() + WS_WOUT); GAS bf16* WGU = (GAS bf16*)(F.wsb() + WS_WGU); GAS bf16* WDN = (GAS bf16*)(F.wsb() + WS_WDN);
    for (int it = gw; it < I_A + I_B + I_C + I_D; it += NGW) {
        int r = it;
        if (r < I_A) { const int nblk = NPROJ / 32, kb = r / nblk, nb = r % nblk; const int sc = win_src(nb * 32 + (lane & 31));
            transpose_tile(F.inp(I_WIN) + (size_t)l * DM * PROJ_ORIG, PROJ_ORIG, sc, WIN + (size_t)(nb * 32) * DM, DM, kb * 64, scr, lane); continue; }
        r -= I_A;
        if (r < I_B) { const int nblk = DM / 32, kb = r / nblk, nb = r % nblk;
            transpose_tile(F.inp(I_WOUT) + (size_t)l * DM * DM, DM, nb * 32 + (lane & 31), WOUT + (size_t)(nb * 32) * DM, DM, kb * 64, scr, lane); continue; }
        r -= I_B;
        if (r < I_C) { const int nblk = NGU / 32, kb = r / nblk, nb = r % nblk; const int n0 = nb * 32, pn = n0 >> 8, rr = n0 & 255;
            const GAS float* src = (rr < 128) ? F.inp(I_WG) : F.inp(I_WU);
            transpose_tile(src + (size_t)l * DM * DFF, DFF, pn * 128 + (rr & 127) + (lane & 31), WGU + (size_t)n0 * DM, DM, kb * 64, scr, lane); continue; }
        r -= I_C;
        { const int nblk = DM / 32, kb = r / nblk, nb = r % nblk;
            transpose_tile(F.inp(I_WD) + (size_t)l * DFF * DM, DM, nb * 32 + (lane & 31), WDN + (size_t)(nb * 32) * DFF, DFF, kb * 64, scr, lane); }
    }
    GAS bf16* W1T = (GAS bf16*)(F.wsb() + WS_W1T); GAS bf16* W2T = (GAS bf16*)(F.wsb() + WS_W2T); GAS float* CBP = (GAS float*)(F.wsb() + WS_CBP);
    for (int it = gw; it < 512 + 16 + 32; it += NGW) {
        int r = it;
        if (r < 512) { const int sel = r >> 8, q = r & 255, kb = q >> 2, nb = q & 3;
            transpose_tile(F.inp(I_CW1) + (size_t)(l * 2 + sel) * 4096 * HD, HD, nb * 32 + (lane & 31), W1T + (size_t)(sel * HD + nb * 32) * 4096, 4096, kb * 64, scr, lane); continue; }
        r -= 512;
        if (r < 16) { const int sel = r >> 3, q = r & 7, kb = q >> 2, nb = q & 3;
            transpose_tile(F.inp(I_CW2) + (size_t)(l * 2 + sel) * HD * HD, HD, nb * 32 + (lane & 31), W2T + (size_t)(sel * HD + nb * 32) * HD, HD, kb * 64, scr, lane); continue; }
        r -= 16;
        { const int sel = r >> 4, ch = r & 15; const GAS float* pe = F.inp(I_CPOS) + (size_t)(l * 2 + sel) * 4096 + ch * 256; const GAS float* w1 = F.inp(I_CW1) + ((size_t)(l * 2 + sel) * 4096 + ch * 256) * HD;
            float h0 = 0.f, h1 = 0.f;
            for (int i = 0; i < 256; ++i) { const float a = pe[i]; h0 += a * w1[(size_t)i * HD + lane]; h1 += a * w1[(size_t)i * HD + 64 + lane]; }
            CBP[(sel * 16 + ch) * HD + lane] = h0; CBP[(sel * 16 + ch) * HD + 64 + lane] = h1; }
    }
}
__device__ __forceinline__ void ph_norm(Frame& F, const GAS float* x, const GAS float* gain) {
    const int gw = F.vcu * NWAVES + F.wave, NGW = F.G * NWAVES, lane = F.lane(); GAS bf16* H = (GAS bf16*)(F.wsb() + WS_H);
    const GAS f32x4* gr = (const GAS f32x4*)gain + lane;
    for (int m = 4 * gw; m < MTOK; m += 4 * NGW) {
        f32x4 v[4][8]; float sq[4];
#pragma unroll
        for (int q = 0; q < 4; ++q)
#pragma unroll
            for (int j = 0; j < 8; ++j) v[q][j] = ((const GAS f32x4*)(x + (size_t)(m + q) * DM) + lane)[64 * j];
#pragma unroll
        for (int q = 0; q < 4; ++q) { float a = 0.f;
#pragma unroll
            for (int j = 0; j < 8; ++j) a += (v[q][j].x * v[q][j].x + v[q][j].y * v[q][j].y) + (v[q][j].z * v[q][j].z + v[q][j].w * v[q][j].w);
            sq[q] = 1.0f / sqrtf(wave_sum(a) * (1.f / DM) + RMS_EPS); }
#pragma unroll
        for (int j = 0; j < 8; ++j) { const f32x4 g = gr[64 * j];
#pragma unroll
            for (int q = 0; q < 4; ++q) { v2u w; w.x = pk2(v[q][j].x * sq[q] * g.x, v[q][j].y * sq[q] * g.y); w.y = pk2(v[q][j].z * sq[q] * g.z, v[q][j].w * sq[q] * g.w);
                ((GAS v2u*)(H + (size_t)(m + q) * DM) + lane)[64 * j] = w; } }
    }
}

typedef short bf16x8 __attribute__((ext_vector_type(8)));
typedef short s16x4 __attribute__((ext_vector_type(4)));
typedef float f32x16 __attribute__((ext_vector_type(16)));
__device__ __forceinline__ int crow(int r, int hi) { return (r & 3) + 8 * (r >> 2) + 4 * hi; }
__device__ __forceinline__ bf16x8 ld16(const GAS bf16* p) { return *(const GAS bf16x8*)p; }
__device__ __forceinline__ bf16x8 ld8x2(const GAS bf16* p) { const s16x4 a = *(const GAS s16x4*)p, b = *(const GAS s16x4*)(p + 8); return (bf16x8){a[0], a[1], a[2], a[3], b[0], b[1], b[2], b[3]}; }
__device__ __forceinline__ bf16x8 pack8f(float a0, float a1, float a2, float a3, float a4, float a5, float a6, float a7) {
    v4u w; w.x = pg8::cvt_pk_bf16(a0, a1); w.y = pg8::cvt_pk_bf16(a2, a3); w.z = pg8::cvt_pk_bf16(a4, a5); w.w = pg8::cvt_pk_bf16(a6, a7); return __builtin_bit_cast(bf16x8, w); }
#define MFMA32(a, b, c) __builtin_amdgcn_mfma_f32_32x32x16_bf16((a), (b), (c), 0, 0, 0)
constexpr float LOG2E = 1.4426950408889634f;

__device__ __forceinline__ void cmp_unit(Frame& F, int l, int it) {
    const int lane = F.lane(), r32 = lane & 31, hi = lane >> 5;
    const int nb = it & 3, r1 = it >> 2, hkv = r1 & 1, r2 = r1 >> 1, b = r2 % NBATCH, sel = r2 / NBATCH;
    const int n = 32 * nb + r32;
    const GAS bf16* P = (const GAS bf16*)(F.wsb() + WS_PROJ);
    const GAS bf16* brow = P + ((size_t)b * SEQ + 16 * n) * NPROJ + PC_NKV + sel * 256 + hkv * 128 + 8 * hi;
    const GAS bf16* W1T = (const GAS bf16*)(F.wsb() + WS_W1T) + (size_t)sel * HD * 4096 + (size_t)r32 * 4096 + 8 * hi;
    f32x16 acc[4];
#pragma unroll
    for (int cb = 0; cb < 4; ++cb) acc[cb] = (f32x16){};
#pragma unroll 1
    for (int li = 4 * F.wave; li < 4 * F.wave + 4; ++li) {
        bf16x8 bfr[8];
#pragma unroll
        for (int q = 0; q < 8; ++q) bfr[q] = ld16(brow + (size_t)li * NPROJ + 16 * q);
#pragma unroll
        for (int q = 0; q < 8; ++q) { const int s = li * 8 + q;
#pragma unroll
            for (int cb = 0; cb < 4; ++cb) acc[cb] = MFMA32(ld16(W1T + (size_t)cb * 32 * 4096 + 16 * s), bfr[q], acc[cb]); }
    }
    LAS float* part = (LAS float*)(F.lds + RING_OFF + F.wave * 16384);
#pragma unroll
    for (int cb = 0; cb < 4; ++cb)
#pragma unroll
        for (int r = 0; r < 16; ++r) part[(cb * 16 + r) * 64 + lane] = acc[cb][r];
    LDS_WAIT();
    __syncthreads();
    if (F.wave != 0) { __syncthreads(); return; }
#pragma unroll 1
    for (int w = 1; w < NWAVES; ++w) { const LAS float* pw = (const LAS float*)(F.lds + RING_OFF + w * 16384);
#pragma unroll
        for (int cb = 0; cb < 4; ++cb)
#pragma unroll
            for (int r = 0; r < 16; ++r) acc[cb][r] += pw[(cb * 16 + r) * 64 + lane]; }
    LAS float* bl = (LAS float*)(F.lds + FL_OFF);
    { const GAS float* cbp = (const GAS float*)(F.wsb() + WS_CBP) + (size_t)sel * 16 * HD; float b0 = 0.f, b1 = 0.f;
      for (int ch = 0; ch < 16; ++ch) { b0 += cbp[ch * HD + lane]; b1 += cbp[ch * HD + 64 + lane]; }
      bl[lane] = b0; bl[64 + lane] = b1; }
    LDS_WAIT();
    bf16x8 hb[4][2];
#pragma unroll
    for (int cb = 0; cb < 4; ++cb) { float hv[16];
#pragma unroll
        for (int r = 0; r < 16; ++r) hv[r] = pg8::silu_f(acc[cb][r] + bl[32 * cb + crow(r, hi)]);
        hb[cb][0] = pack8f(hv[0], hv[1], hv[2], hv[3], hv[4], hv[5], hv[6], hv[7]); hb[cb][1] = pack8f(hv[8], hv[9], hv[10], hv[11], hv[12], hv[13], hv[14], hv[15]); }
    LDS_WAIT();
    const GAS bf16* W2T = (const GAS bf16*)(F.wsb() + WS_W2T) + (size_t)sel * HD * HD + (size_t)r32 * HD + 4 * hi;
    f32x16 o2[4];
#pragma unroll
    for (int c2b = 0; c2b < 4; ++c2b) { o2[c2b] = (f32x16){};
        bf16x8 wf[8];
#pragma unroll
        for (int i = 0; i < 8; ++i) wf[i] = ld8x2(W2T + (size_t)c2b * 32 * HD + 32 * (i >> 1) + 16 * (i & 1));
#pragma unroll
        for (int i = 0; i < 8; ++i) o2[c2b] = MFMA32(wf[i], hb[i >> 1][i & 1], o2[c2b]); }
    if (sel == 0) {
        float ss = 0.f;
#pragma unroll
        for (int c2b = 0; c2b < 4; ++c2b)
#pragma unroll
            for (int r = 0; r < 16; ++r) ss += o2[c2b][r] * o2[c2b][r];
        ss = sum32(ss);
        const float rs = 1.0f / sqrtf(ss * (1.f / HD) + RMS_EPS); const GAS float* kn = F.inp(I_NKN) + (size_t)(l * 3) * HD;
        GAS bf16* dst = (GAS bf16*)(F.wsb() + WS_KCB) + ((size_t)(b * NHKV + hkv) * 128 + n) * HD;
#pragma unroll
        for (int c2b = 0; c2b < 4; ++c2b)
#pragma unroll
            for (int g = 0; g < 4; ++g) { const int c2 = 32 * c2b + 8 * g + 4 * hi; const f32x4 gn = *(const GAS f32x4*)(kn + c2);
                v2u w; w.x = pk2(o2[c2b][4 * g] * rs * gn.x, o2[c2b][4 * g + 1] * rs * gn.y); w.y = pk2(o2[c2b][4 * g + 2] * rs * gn.z, o2[c2b][4 * g + 3] * rs * gn.w);
                if (n == 127) { w.x = 0u; w.y = 0u; }
                *(GAS v2u*)(dst + c2) = w; }
    } else {
        GAS bf16* dst = (GAS bf16*)(F.wsb() + WS_VCT) + (size_t)(b * NHKV + hkv) * HD * 128 + n;
#pragma unroll
        for (int c2b = 0; c2b < 4; ++c2b)
#pragma unroll
            for (int r = 0; r < 16; ++r) dst[(size_t)(32 * c2b + crow(r, hi)) * 128] = (n == 127) ? (bf16)0 : (bf16)f2bf(o2[c2b][r]);
    }
    __syncthreads();
}

__device__ __forceinline__ void load_q(const GAS bf16* qrow, const LAS float* qn, int hi, bf16x8 (&qf)[8], float& qnorm) {
    v4u raw[8]; float ss = 0.f;
#pragma unroll
    for (int ks = 0; ks < 8; ++ks) raw[ks] = *(const GAS v4u*)(qrow + 16 * ks + 8 * hi);
    asm volatile("" ::: "memory");
#pragma unroll
    for (int ks = 0; ks < 8; ++ks)
#pragma unroll
        for (int i = 0; i < 4; ++i) { const float a = bflo(raw[ks][i]), b = bfhi(raw[ks][i]); ss += a * a + b * b; }
    ss = sum32(ss);
    const float rs = (1.0f / sqrtf(ss * (1.f / HD) + RMS_EPS)) * 0.08838834764831845f;
    float n2 = 0.f;
#pragma unroll
    for (int ks = 0; ks < 8; ++ks) { const f32x4 g0 = *(const LAS f32x4*)(qn + 16 * ks + 8 * hi), g1 = *(const LAS f32x4*)(qn + 16 * ks + 8 * hi + 4);
        float f[8];
#pragma unroll
        for (int i = 0; i < 4; ++i) { f[2 * i] = bflo(raw[ks][i]) * rs; f[2 * i + 1] = bfhi(raw[ks][i]) * rs; }
        f[0] *= g0.x; f[1] *= g0.y; f[2] *= g0.z; f[3] *= g0.w; f[4] *= g1.x; f[5] *= g1.y; f[6] *= g1.z; f[7] *= g1.w;
#pragma unroll
        for (int i = 0; i < 8; ++i) n2 += f[i] * f[i];
        qf[ks] = pack8f(f[0], f[1], f[2], f[3], f[4], f[5], f[6], f[7]); }
    n2 = sum32(n2);
    qnorm = sqrtf(n2);
}

__device__ __forceinline__ void nsa_select_unit(Frame& F, int l, int item, LAS float* wl, const LAS float* btab2, float kmax, float bmax) {
    const int lane = F.lane(), r32 = lane & 31, hi = lane >> 5;
    const int tt = item & 63, r1 = item >> 6, hkv = r1 & 1, b = r1 >> 1, t = 32 * tt + r32; const size_t m = (size_t)b * SEQ + t;
    const GAS bf16* P = (const GAS bf16*)(F.wsb() + WS_PROJ);
    const GAS bf16* KCB = (const GAS bf16*)(F.wsb() + WS_KCB) + (size_t)(b * NHKV + hkv) * 128 * HD + (size_t)r32 * HD + 8 * hi;
#pragma unroll 1
    for (int g = 0; g < 3; ++g) { const int h = hkv * 3 + g; const LAS float* bt = btab2 + h * 132;
        bf16x8 qf[8]; float qnorm;
        load_q(P + m * NPROJ + PC_NQ + h * HD, (const LAS float*)(F.lds + BTAB_OFF + 3200), hi, qf, qnorm);
        const float shift = -(qnorm * kmax + bmax) * LOG2E;
        f32x16 p[4]; float ls = 0.f;
#pragma unroll
        for (int nb = 0; nb < 4; ++nb) { p[nb] = (f32x16){};
#pragma unroll
            for (int k4 = 0; k4 < 2; ++k4) { bf16x8 kf[4];
#pragma unroll
                for (int ks = 0; ks < 4; ++ks) kf[ks] = ld16(KCB + (size_t)nb * 32 * HD + 16 * (4 * k4 + ks));
#pragma unroll
                for (int ks = 0; ks < 4; ++ks) p[nb] = MFMA32(kf[ks], qf[4 * k4 + ks], p[nb]); }
#pragma unroll
            for (int r = 0; r < 16; ++r) { const int n = 32 * nb + crow(r, hi); const int dist = t - 16 * n - 31; const int di = dist < 0 ? 0 : (dist > 128 ? 128 : dist);
                const float tb = bt[di] + shift; const float ee = __builtin_amdgcn_exp2f(__builtin_fmaf(p[nb][r], LOG2E, tb)); const float e = dist >= 0 ? ee : 0.f; p[nb][r] = e; ls += e; } }
        ls = sum32(ls);
        const float inv = ls > 0.f ? 1.0f / ls : 0.f;
#pragma unroll
        for (int nb = 0; nb < 4; ++nb)
#pragma unroll
            for (int r = 0; r < 16; ++r) { LAS float* w = wl + (32 * nb + crow(r, hi)) * 32 + r32; const float v = p[nb][r] * inv; *w = (g == 0) ? v : (*w + v); }
    }
    LDS_WAIT();
    float val[32];
#pragma unroll
    for (int j = 0; j < 32; ++j) val[j] = 0.f;
#pragma unroll
    for (int n = 0; n < 127; ++n) { const float v = wl[n * 32 + r32]; val[n >> 2] += v; if ((n & 3) == 3 && (n >> 2) + 1 < 32) val[(n >> 2) + 1] += v; }
    const int cur = t >> 6;
#pragma unroll
    for (int j = 0; j < 32; ++j) val[j] = (j > cur) ? -1.0f : ((j == 0 || j == cur || j == cur - 1) ? 1.0e4f : val[j]);
    unsigned mask = 0u;
#pragma unroll 1
    for (int itx = 0; itx < 8; ++itx) { float best = val[0]; int bj = 0;
#pragma unroll
        for (int j = 1; j < 32; ++j) if (val[j] > best) { best = val[j]; bj = j; }
        mask |= 1u << bj;
#pragma unroll
        for (int j = 0; j < 32; ++j) val[j] = (j == bj) ? -3.0e38f : val[j]; }
    if (hi == 0) ((GAS unsigned*)(F.wsb() + WS_SEL))[(size_t)(b * NHKV + hkv) * SEQ + t] = mask;
    LDS_WAIT();
}

template <int KIND  >
__device__ __forceinline__ float attn_softmax_tile(f32x16& p, int base, int t, int t0, int hi, float shift, float farb, const LAS float* bt, bool rowsel) {
    const bool nearb = (KIND == 0) ? true : ((t0 - base - 31) < 128);
    if (nearb) {
#pragma unroll
        for (int r = 0; r < 16; ++r) { const int c = crow(r, hi); const int d0 = (KIND == 0) ? (t - 16 * (base + c) - 31) : (t - (base + c)); const int i0 = d0 < 0 ? 0 : (d0 > 128 ? 128 : d0); p[r] = __builtin_fmaf(p[r], LOG2E, bt[i0] + shift); }
    } else {
#pragma unroll
        for (int r = 0; r < 16; ++r) p[r] = __builtin_fmaf(p[r], LOG2E, farb);
    }
    float ps = 0.f;
#pragma unroll
    for (int r = 0; r < 16; ++r) {
        const int c = crow(r, hi);
        const int d0 = (KIND == 0) ? (t - 16 * (base + c) - 31) : (t - (base + c));
        const bool v0 = (KIND == 0) ? (d0 >= 0) : ((KIND == 1) ? (rowsel && d0 >= 0) : ((unsigned)d0 < 512u));
        const float e = __builtin_amdgcn_exp2f(p[r]);
        const float e0 = v0 ? e : 0.f;
        p[r] = e0; ps += e0;
    }
    return ps;
}
__device__ __forceinline__ void attn_branch_end(f32x16 (&O)[4], float& lsum, float gate, LAS unsigned* yl, LAS float* fl, int lane, int r32, int hi, bool first) {
    float lt = sum32(lsum);
    const float f = lt > 0.f ? gate / lt : 0.f;
    if (hi == 0) fl[r32] = f;
    LDS_WAIT();
    float fr[16];
#pragma unroll
    for (int r = 0; r < 16; ++r) fr[r] = fl[crow(r, hi)];
#pragma unroll
    for (int db = 0; db < 4; ++db)
#pragma unroll
        for (int r2 = 0; r2 < 8; ++r2) { LAS unsigned* y = yl + (db * 8 + r2) * 64 + lane; float v0 = O[db][2 * r2] * fr[2 * r2], v1 = O[db][2 * r2 + 1] * fr[2 * r2 + 1];
            if (!first) { const unsigned w = *y; v0 += bflo(w); v1 += bfhi(w); }
            *y = pg8::cvt_pk_bf16(v0, v1); }
#pragma unroll
    for (int db = 0; db < 4; ++db) O[db] = (f32x16){};
    lsum = 0.f;
    LDS_WAIT();
}
__device__ __forceinline__ void nsa_attn_block(Frame& F, int l, int unit, int g, const LAS float* btab2, float kmax, float bmax) {
    const int lane = F.lane(), r32 = lane & 31, hi = lane >> 5, w = F.wave;
    const unsigned lo8 = (unsigned)lane * 8u;
    const int qb = 7 - unit / 32, grp = unit % 32, b = grp >> 1, hkv = grp & 1, T0 = qb * 256, t0 = T0 + 32 * w, t = t0 + r32; const size_t m = (size_t)b * SEQ + t;
    const GAS bf16* P = (const GAS bf16*)(F.wsb() + WS_PROJ);
    LAS bf16* kb = (LAS bf16*)(F.lds + RING_OFF); LAS bf16* vb = (LAS bf16*)(F.lds + RING_OFF + 16384);
    LAS unsigned* yl = (LAS unsigned*)(F.lds + RING_OFF + 32768 + w * 8192); LAS float* fl = (LAS float*)(F.lds + FL_OFF + w * 1024);
    const GAS bf16* KC = (const GAS bf16*)(F.wsb() + WS_KCB) + (size_t)(b * NHKV + hkv) * 128 * HD; const GAS bf16* VC = (const GAS bf16*)(F.wsb() + WS_VCT) + (size_t)(b * NHKV + hkv) * HD * 128;
    const GAS bf16* KSn = (const GAS bf16*)(F.wsb() + WS_KN) + (size_t)((0 * NBATCH + b) * NHKV + hkv) * 64 * 4096; const GAS bf16* KWn = (const GAS bf16*)(F.wsb() + WS_KN) + (size_t)((1 * NBATCH + b) * NHKV + hkv) * 64 * 4096;
    const GAS bf16* VSn = (const GAS bf16*)(F.wsb() + WS_VT) + (size_t)((0 * NBATCH + b) * NHKV + hkv) * 64 * 4096; const GAS bf16* VWn = (const GAS bf16*)(F.wsb() + WS_VT) + (size_t)((1 * NBATCH + b) * NHKV + hkv) * 64 * 4096;
    const unsigned mymask = ((const GAS unsigned*)(F.wsb() + WS_SEL))[(size_t)(b * NHKV + hkv) * SEQ + t];
    unsigned unw = wave_or(mymask); unw = (unsigned)__builtin_amdgcn_readfirstlane((int)unw);
    const int curmax = (T0 + 255) >> 6, ns = 2 * (curmax + 1), ilo = (T0 - 511 > 0 ? T0 - 511 : 0) >> 5, ihi = (T0 + 255) >> 5, total = ns + (ihi - ilo + 1);
    {
        const int h = hkv * 3 + g; const LAS float* bt = btab2 + h * 132;
        bf16x8 qf[8]; float qnorm;
        load_q(P + m * NPROJ + PC_NQ + h * HD, (const LAS float*)(F.lds + BTAB_OFF + 3200), hi, qf, qnorm);
        const float shift = -(qnorm * kmax + bmax) * LOG2E, farb = bt[128] + shift;
        f32x16 O[4];
#pragma unroll
        for (int db = 0; db < 4; ++db) O[db] = (f32x16){};
        float lsum = 0.f;
        { const int nvis = (t0 >> 4) + 1; int cnt = (nvis + 31) >> 5; if (cnt > 4) cnt = 4;
#pragma unroll 1
          for (int ti = 0; ti < cnt; ++ti) { const int base = 32 * ti;
              bf16x8 kf[8], vf[8];
#pragma unroll
              for (int ks = 0; ks < 8; ++ks) kf[ks] = ld16(KC + (size_t)(base + r32) * HD + 8 * hi + 16 * ks);
#pragma unroll
              for (int db = 0; db < 4; ++db)
#pragma unroll
                  for (int ks = 0; ks < 2; ++ks) vf[db * 2 + ks] = ld8x2(VC + (size_t)(32 * db + r32) * 128 + base + 16 * ks + 4 * hi);
              f32x16 p = (f32x16){};
#pragma unroll
              for (int ks = 0; ks < 8; ++ks) p = MFMA32(kf[ks], qf[ks], p);
              lsum += attn_softmax_tile<0>(p, base, t, t0, hi, shift, farb, bt, true);
              const bf16x8 pa0 = pack8f(p[0], p[1], p[2], p[3], p[4], p[5], p[6], p[7]), pa1 = pack8f(p[8], p[9], p[10], p[11], p[12], p[13], p[14], p[15]);
#pragma unroll
              for (int db = 0; db < 4; ++db) { O[db] = MFMA32(pa0, vf[db * 2], O[db]); O[db] = MFMA32(pa1, vf[db * 2 + 1], O[db]); } }
          const float g0 = sigmoid_f(bf2f(P[m * NPROJ + PC_NG + 0 * 6 + h]));
          attn_branch_end(O, lsum, g0, yl, fl, lane, r32, hi, true); }
        __syncthreads();
        { const GAS bf16* ks0 = KSn + (size_t)w * 512 + lo8; const GAS bf16* vs0 = VSn + (size_t)w * 512 + lo8;
          *(LAS v4u*)(kb + w * 512 + lo8) = *(const GAS v4u*)ks0; *(LAS v4u*)(vb + w * 512 + lo8) = *(const GAS v4u*)vs0; }
#pragma unroll 1
        for (int idx = 0; idx < total; ++idx) {
            __syncthreads();
            const bool issel = idx < ns; const int base = issel ? 32 * idx : 32 * (ilo + idx - ns);
            v4u kr, vr; const bool nxt = idx + 1 < total;
            if (nxt) { const int i1 = idx + 1; const bool s1 = i1 < ns; const int tile1 = s1 ? i1 : (ilo + i1 - ns);
                kr = *(const GAS v4u*)((s1 ? KSn : KWn) + (size_t)tile1 * 4096 + w * 512 + lo8); vr = *(const GAS v4u*)((s1 ? VSn : VWn) + (size_t)tile1 * 4096 + w * 512 + lo8); }
            const LAS bf16* kt = kb + (idx & 1) * 4096; const LAS bf16* vt = vb + (idx & 1) * 4096;
            const bool need = issel ? ((((unw >> (base >> 6)) & 1u) != 0u) && base <= t0 + 31) : (base + 31 >= t0 - 511 && base <= t0 + 31);
            if (need) {
                f32x16 p = (f32x16){};
                { bf16x8 k4[4];
#pragma unroll
                  for (int ks = 0; ks < 4; ++ks) k4[ks] = *(const LAS bf16x8*)(kt + ks * 512 + lo8);
#pragma unroll
                  for (int ks = 0; ks < 4; ++ks) p = MFMA32(k4[ks], qf[ks], p);
#pragma unroll
                  for (int ks = 0; ks < 4; ++ks) k4[ks] = *(const LAS bf16x8*)(kt + (4 + ks) * 512 + lo8);
#pragma unroll
                  for (int ks = 0; ks < 4; ++ks) p = MFMA32(k4[ks], qf[4 + ks], p); }
                lsum += issel ? attn_softmax_tile<1>(p, base, t, t0, hi, shift, farb, bt, ((mymask >> (base >> 6)) & 1u) != 0u) : attn_softmax_tile<2>(p, base, t, t0, hi, shift, farb, bt, true);
                const bf16x8 pa0 = pack8f(p[0], p[1], p[2], p[3], p[4], p[5], p[6], p[7]), pa1 = pack8f(p[8], p[9], p[10], p[11], p[12], p[13], p[14], p[15]);
#pragma unroll
                for (int db = 0; db < 4; ++db) { const bf16x8 v0 = *(const LAS bf16x8*)(vt + (db * 2) * 512 + lo8), v1 = *(const LAS bf16x8*)(vt + (db * 2 + 1) * 512 + lo8);
                    O[db] = MFMA32(pa0, v0, O[db]); O[db] = MFMA32(pa1, v1, O[db]); }
            }
            if (idx == ns - 1) { const float g1 = sigmoid_f(bf2f(P[m * NPROJ + PC_NG + 1 * 6 + h])); attn_branch_end(O, lsum, g1, yl, fl, lane, r32, hi, false); }
            if (nxt) { *(LAS v4u*)(kb + ((idx + 1) & 1) * 4096 + w * 512 + lo8) = kr; *(LAS v4u*)(vb + ((idx + 1) & 1) * 4096 + w * 512 + lo8) = vr; }
        }
        { const float g2 = sigmoid_f(bf2f(P[m * NPROJ + PC_NG + 2 * 6 + h])); float lt = sum32(lsum); const float f = lt > 0.f ? g2 / lt : 0.f;
          if (hi == 0) fl[r32] = f;
          LDS_WAIT();
          int lane2 = lane; asm volatile("" : "+v"(lane2));
          const int r32b = lane2 & 31, hib = lane2 >> 5;
          GAS bf16* Y = (GAS bf16*)(F.wsb() + WS_H) + ((size_t)b * SEQ + t0) * DM + 768 + h * HD + r32b + (size_t)(4 * hib) * DM;
#pragma unroll
          for (int r2 = 0; r2 < 8; ++r2) { const float fq0 = fl[crow(2 * r2, 0) + 4 * hib], fq1 = fl[crow(2 * r2 + 1, 0) + 4 * hib];
#pragma unroll
              for (int db = 0; db < 4; ++db) { const unsigned yw = yl[(db * 8 + r2) * 64 + lane2]; const float v0 = bflo(yw) + O[db][2 * r2] * fq0, v1 = bfhi(yw) + O[db][2 * r2 + 1] * fq1; const float n0 = xl1(v0), n1 = xl1(v1);
                  if ((r32b & 1) == 0) { *(GAS unsigned*)(Y + (size_t)crow(2 * r2, 0) * DM + 32 * db) = pk2(v0, n0); *(GAS unsigned*)(Y + (size_t)crow(2 * r2 + 1, 0) * DM + 32 * db) = pk2(v1, n1); } } }
          LDS_WAIT(); }
    }
    __syncthreads();
}

__device__ __forceinline__ float softplus_f(float x) { return fmaxf(x, 0.f) + __logf(1.0f + __expf(-fabsf(x))); }
__device__ __forceinline__ void ph_mix1(Frame& F, int l) {
    const int gw = F.vcu * NWAVES + F.wave, NGW = F.G * NWAVES, lane = F.lane();
    const GAS bf16* P = (const GAS bf16*)(F.wsb() + WS_PROJ);
    {
        GAS bf16* GQ = (GAS bf16*)(F.wsb() + WS_GQ); GAS bf16* GK = (GAS bf16*)(F.wsb() + WS_GK); GAS bf16* GV = (GAS bf16*)(F.wsb() + WS_GV);
        GAS float* GB = (GAS float*)(F.wsb() + WS_GBG); GAS float* GG = GB + NBATCH * GH * SEQ;
        const GAS float* cw = F.inp(I_GCONV) + (size_t)l * 2304 * 4;
        for (int it = gw; it < NBATCH * (SEQ / 8) * GH; it += NGW) {
            const int h = it % GH, r1 = it / GH, tb = r1 % (SEQ / 8), b = r1 / (SEQ / 8), t0 = tb * 8; const size_t m0 = (size_t)b * SEQ + t0;
            unsigned raw[3][11];
#pragma unroll
            for (int p = 0; p < 3; ++p)
#pragma unroll
                for (int j = 0; j < 11; ++j) { const int tt = t0 - 3 + j; raw[p][j] = (tt >= 0) ? *(const GAS unsigned*)(P + (m0 - 3 + j) * NPROJ + PC_GQKV + p * 768 + h * 128 + 2 * lane) : 0u; }
            float bb = 0.f, aa = 0.f;
            if (lane < 8) { bb = bf2f(P[(m0 + lane) * NPROJ + PC_GB + h]); aa = bf2f(P[(m0 + lane) * NPROJ + PC_GA + h]); }
            f32x4 w0[3], w1[3];
#pragma unroll
            for (int p = 0; p < 3; ++p) { const int ch = p * 768 + h * 128 + 2 * lane; w0[p] = *(const GAS f32x4*)(cw + (size_t)ch * 4); w1[p] = *(const GAS f32x4*)(cw + (size_t)(ch + 1) * 4); }
            const size_t o0 = ((size_t)(b * GH + h) * SEQ + t0) * HD + 2 * lane;
#pragma unroll
            for (int i = 0; i < 8; ++i) {
                float val[3][2];
#pragma unroll
                for (int p = 0; p < 3; ++p) { float a0 = 0.f, a1 = 0.f;
#pragma unroll
                    for (int j = 0; j < 4; ++j) { a0 += bflo(raw[p][i + j]) * w0[p][j]; a1 += bfhi(raw[p][i + j]) * w1[p][j]; }
                    val[p][0] = pg8::silu_f(a0); val[p][1] = pg8::silu_f(a1); }
                const float sq = wave_sum(val[0][0] * val[0][0] + val[0][1] * val[0][1]), sk = wave_sum(val[1][0] * val[1][0] + val[1][1] * val[1][1]);
                const float rq = (1.0f / sqrtf(sq + RMS_EPS)) * 0.08838834764831845f, rk = 1.0f / sqrtf(sk + RMS_EPS);
                *(GAS unsigned*)(GQ + o0 + (size_t)i * HD) = pk2(val[0][0] * rq, val[0][1] * rq);
                *(GAS unsigned*)(GK + o0 + (size_t)i * HD) = pk2(val[1][0] * rk, val[1][1] * rk);
                *(GAS unsigned*)(GV + o0 + (size_t)i * HD) = pk2(val[2][0], val[2][1]);
            }
            if (lane < 8) {
                GB[(size_t)(b * GH + h) * SEQ + t0 + lane] = sigmoid_f(bb);
                GG[(size_t)(b * GH + h) * SEQ + t0 + lane] = -__expf(F.inp(I_GALOG)[l * GH + h]) * softplus_f(aa + F.inp(I_GDT)[l * GH + h]);
            }
        }
    }
    __syncthreads();
    for (int it = F.vcu; it < 2 * NBATCH * NHKV * 4; it += F.G) cmp_unit(F, l, it);
}

__device__ __forceinline__ void gdn_chunk_unit(Frame& F, int item, LAS float* wl, LAS float* sl) {
    const int lane = F.lane(), r32 = lane & 31, hi = lane >> 5;
    const size_t tok0 = (size_t)item * 64;
    GAS bf16* GQ = (GAS bf16*)(F.wsb() + WS_GQ) + tok0 * HD; GAS bf16* GK = (GAS bf16*)(F.wsb() + WS_GK) + tok0 * HD; GAS bf16* GV = (GAS bf16*)(F.wsb() + WS_GV) + tok0 * HD;
    const GAS float* GB = (const GAS float*)(F.wsb() + WS_GBG) + tok0; const GAS float* GG = GB + NBATCH * GH * SEQ;
    float gc = GG[lane]; const float beta = GB[lane];
#pragma unroll
    for (int o = 1; o < 64; o <<= 1) { const float v = __int_as_float(__builtin_amdgcn_ds_bpermute((lane - o) << 2, __float_as_int(gc))); if (lane >= o) gc += v; }
    const float glast = rl(gc, 63);
    sl[lane] = gc; sl[64 + lane] = beta; sl[128 + lane] = __expf(gc); sl[192 + lane] = __expf(glast - gc);
    if (lane == 0) ((GAS float*)(F.wsb() + WS_EGL))[item] = __expf(glast);
    LDS_WAIT();
    {
        bf16x8 kfr[2][8];
#pragma unroll
        for (int rb = 0; rb < 2; ++rb)
#pragma unroll
            for (int ks = 0; ks < 8; ++ks) kfr[rb][ks] = ld16(GK + (size_t)(32 * rb + r32) * HD + 16 * ks + 8 * hi);
#pragma unroll
        for (int tI = 0; tI < 3; ++tI) { const int rb = (tI == 2) ? 1 : 0, cb = (tI == 0) ? 0 : 1;
            f32x16 acc = (f32x16){};
#pragma unroll
            for (int ks = 0; ks < 8; ++ks) acc = MFMA32(kfr[rb][ks], kfr[cb][ks], acc);
            const int s_ = 32 * cb + r32; const float gcs = sl[s_], bs = sl[64 + s_];
#pragma unroll
            for (int r = 0; r < 16; ++r) { const int c = 32 * rb + crow(r, hi); wl[c * 64 + s_] = (s_ > c) ? bs * acc[r] * __expf(gcs - sl[c]) : 0.f; }
        }
        GAS bf16* ATT = (GAS bf16*)(F.wsb() + WS_ATT) + (size_t)item * 4096;
#pragma unroll
        for (int ib = 0; ib < 2; ++ib) {
            bf16x8 qfr[8];
#pragma unroll
            for (int ks = 0; ks < 8; ++ks) qfr[ks] = ld16(GQ + (size_t)(32 * ib + r32) * HD + 16 * ks + 8 * hi);
            const int i_ = 32 * ib + r32; const float gci = sl[i_];
#pragma unroll
            for (int jb = 0; jb < 2; ++jb) { f32x16 acc = (f32x16){};
                if (!(ib == 0 && jb == 1)) {
#pragma unroll
                    for (int ks = 0; ks < 8; ++ks) acc = MFMA32(kfr[jb][ks], qfr[ks], acc);
                }
                float av[16];
#pragma unroll
                for (int r = 0; r < 16; ++r) { const int j_ = 32 * jb + crow(r, hi); av[r] = (j_ <= i_) ? acc[r] * __expf(gci - sl[j_]) : 0.f; }
                *(GAS bf16x8*)(ATT + ((ib * 4 + jb * 2 + 0) * 64 + lane) * 8) = pack8f(av[0], av[1], av[2], av[3], av[4], av[5], av[6], av[7]);
                *(GAS bf16x8*)(ATT + ((ib * 4 + jb * 2 + 1) * 64 + lane) * 8) = pack8f(av[8], av[9], av[10], av[11], av[12], av[13], av[14], av[15]); }
        }
    }
    LDS_WAIT();
    float yv[64];
#pragma unroll
    for (int c = 63; c >= 0; --c) {
        float acc = (c == lane) ? 1.0f : 0.0f;
#pragma unroll
        for (int s4 = ((c + 1) & ~3); s4 < 64; s4 += 4) { const f32x4 mv = *(const LAS f32x4*)(wl + c * 64 + s4);
            if (s4 + 0 > c) acc = __builtin_fmaf(-mv.x, yv[s4 + 0], acc); if (s4 + 1 > c) acc = __builtin_fmaf(-mv.y, yv[s4 + 1], acc); if (s4 + 2 > c) acc = __builtin_fmaf(-mv.z, yv[s4 + 2], acc); if (s4 + 3 > c) acc = __builtin_fmaf(-mv.w, yv[s4 + 3], acc); }
        yv[c] = acc;
        asm volatile("" ::: "memory");
    }
    unsigned au[4][2][4], aw[4][2][4];
#pragma unroll
    for (int ks = 0; ks < 4; ++ks) { unsigned pu[8], pw[8];
#pragma unroll
        for (int d = 0; d < 8; ++d) { const int c0 = 16 * ks + 2 * d; const float b0 = sl[64 + c0], b1 = sl[64 + c0 + 1], e0 = sl[128 + c0], e1 = sl[128 + c0 + 1];
            pu[d] = pg8::cvt_pk_bf16(yv[c0] * b0, yv[c0 + 1] * b1); pw[d] = pg8::cvt_pk_bf16(yv[c0] * b0 * e0, yv[c0 + 1] * b1 * e1); }
#pragma unroll
        for (int i = 0; i < 4; ++i) { auto ru = __builtin_amdgcn_permlane32_swap(pu[i], pu[4 + i], false, false); au[ks][0][i] = ru[0]; au[ks][1][i] = ru[1];
            auto rw = __builtin_amdgcn_permlane32_swap(pw[i], pw[4 + i], false, false); aw[ks][0][i] = rw[0]; aw[ks][1][i] = rw[1]; } }
    LDS_WAIT();
    LAS bf16* tl = (LAS bf16*)wl;
    {
#pragma unroll
        for (int i = 0; i < 16; ++i) { const int row = 4 * i + (lane >> 4), chn = lane & 15; *(LAS v4u*)(tl + row * HD + 8 * chn) = *(const GAS v4u*)(GV + (size_t)row * HD + 8 * chn); }
        LDS_WAIT();
        GAS bf16* GU = (GAS bf16*)(F.wsb() + WS_GU) + (size_t)item * 8192;
#pragma unroll 1
        for (int eb = 0; eb < 4; ++eb) { f32x16 a0 = (f32x16){}, a1 = (f32x16){};
#pragma unroll
            for (int ks = 0; ks < 4; ++ks) { unsigned w[4];
#pragma unroll
                for (int j = 0; j < 4; ++j) w[j] = (unsigned)tl[(16 * ks + 8 * hi + 2 * j) * HD + 32 * eb + r32] | ((unsigned)tl[(16 * ks + 8 * hi + 2 * j + 1) * HD + 32 * eb + r32] << 16);
                v4u bw; bw.x = w[0]; bw.y = w[1]; bw.z = w[2]; bw.w = w[3]; const bf16x8 bfr = __builtin_bit_cast(bf16x8, bw);
                v4u x0; x0.x = au[ks][0][0]; x0.y = au[ks][0][1]; x0.z = au[ks][0][2]; x0.w = au[ks][0][3]; v4u x1; x1.x = au[ks][1][0]; x1.y = au[ks][1][1]; x1.z = au[ks][1][2]; x1.w = au[ks][1][3];
                a0 = MFMA32(__builtin_bit_cast(bf16x8, x0), bfr, a0); a1 = MFMA32(__builtin_bit_cast(bf16x8, x1), bfr, a1); }
            for (int hf = 0; hf < 2; ++hf) { v4u w0, w1;
                w0.x = pg8::cvt_pk_bf16(a0[8 * hf + 0], a0[8 * hf + 1]); w0.y = pg8::cvt_pk_bf16(a0[8 * hf + 2], a0[8 * hf + 3]); w0.z = pg8::cvt_pk_bf16(a0[8 * hf + 4], a0[8 * hf + 5]); w0.w = pg8::cvt_pk_bf16(a0[8 * hf + 6], a0[8 * hf + 7]);
                w1.x = pg8::cvt_pk_bf16(a1[8 * hf + 0], a1[8 * hf + 1]); w1.y = pg8::cvt_pk_bf16(a1[8 * hf + 2], a1[8 * hf + 3]); w1.z = pg8::cvt_pk_bf16(a1[8 * hf + 4], a1[8 * hf + 5]); w1.w = pg8::cvt_pk_bf16(a1[8 * hf + 6], a1[8 * hf + 7]);
                *(GAS v4u*)(GU + ((eb * 2 + 0) * 64 + lane) * 16 + 8 * hf) = w0; *(GAS v4u*)(GU + ((eb * 2 + 1) * 64 + lane) * 16 + 8 * hf) = w1; } }
        LDS_WAIT();
    }
    {
#pragma unroll
        for (int i = 0; i < 16; ++i) { const int row = 4 * i + (lane >> 4), chn = lane & 15; *(LAS v4u*)(tl + row * HD + 8 * chn) = *(const GAS v4u*)(GK + (size_t)row * HD + 8 * chn); }
        LDS_WAIT();
#pragma unroll 1
        for (int db = 0; db < 4; ++db) { f32x16 a0 = (f32x16){}, a1 = (f32x16){};
#pragma unroll
            for (int ks = 0; ks < 4; ++ks) { unsigned w[4];
#pragma unroll
                for (int j = 0; j < 4; ++j) w[j] = (unsigned)tl[(16 * ks + 8 * hi + 2 * j) * HD + 32 * db + r32] | ((unsigned)tl[(16 * ks + 8 * hi + 2 * j + 1) * HD + 32 * db + r32] << 16);
                v4u bw; bw.x = w[0]; bw.y = w[1]; bw.z = w[2]; bw.w = w[3]; const bf16x8 kT = __builtin_bit_cast(bf16x8, bw);
                v4u x0; x0.x = aw[ks][0][0]; x0.y = aw[ks][0][1]; x0.z = aw[ks][0][2]; x0.w = aw[ks][0][3]; v4u x1; x1.x = aw[ks][1][0]; x1.y = aw[ks][1][1]; x1.z = aw[ks][1][2]; x1.w = aw[ks][1][3];
                a0 = MFMA32(kT, __builtin_bit_cast(bf16x8, x0), a0); a1 = MFMA32(kT, __builtin_bit_cast(bf16x8, x1), a1); }
#pragma unroll
            for (int s2 = 0; s2 < 2; ++s2) {
                *(GAS bf16x8*)(GV + ((0 * 8 + db * 2 + s2) * 64 + lane) * 8) = pack8f(-a0[8 * s2 + 0], -a0[8 * s2 + 1], -a0[8 * s2 + 2], -a0[8 * s2 + 3], -a0[8 * s2 + 4], -a0[8 * s2 + 5], -a0[8 * s2 + 6], -a0[8 * s2 + 7]);
                *(GAS bf16x8*)(GV + ((1 * 8 + db * 2 + s2) * 64 + lane) * 8) = pack8f(-a1[8 * s2 + 0], -a1[8 * s2 + 1], -a1[8 * s2 + 2], -a1[8 * s2 + 3], -a1[8 * s2 + 4], -a1[8 * s2 + 5], -a1[8 * s2 + 6], -a1[8 * s2 + 7]); } }
#pragma unroll 1
        for (int db = 0; db < 4; ++db)
#pragma unroll
            for (int f = 0; f < 4; ++f) { float v[8];
#pragma unroll
                for (int j = 0; j < 8; ++j) { const int c = 32 * (f >> 1) + 16 * (f & 1) + 8 * (j >> 2) + 4 * hi + (j & 3); v[j] = bf2f(tl[c * HD + 32 * db + r32]) * sl[192 + c]; }
                *(GAS bf16x8*)(GK + ((db * 4 + f) * 64 + lane) * 8) = pack8f(v[0], v[1], v[2], v[3], v[4], v[5], v[6], v[7]); }
        LDS_WAIT();
    }
    {
        bf16x8 qa[16];
#pragma unroll
        for (int i = 0; i < 16; ++i) qa[i] = ld8x2(GQ + (size_t)(32 * (i >> 3) + r32) * HD + 32 * ((i >> 1) & 3) + 16 * (i & 1) + 4 * hi);
        const float e0 = sl[128 + r32], e1 = sl[128 + 32 + r32];
        asm volatile("s_waitcnt vmcnt(0)" ::: "memory");
#pragma unroll
        for (int i = 0; i < 16; ++i) { const float e = (i < 8) ? e0 : e1; const v4u w = __builtin_bit_cast(v4u, qa[i]);
            *(GAS bf16x8*)(GQ + (i * 64 + lane) * 8) = pack8f(bflo(w.x) * e, bfhi(w.x) * e, bflo(w.y) * e, bfhi(w.y) * e, bflo(w.z) * e, bfhi(w.z) * e, bflo(w.w) * e, bfhi(w.w) * e); }
    }
    LDS_WAIT();
}
__device__ __forceinline__ void gdn_scan_block(Frame& F, int bh) {
    const int lane = F.lane(), r32 = lane & 31, hi = lane >> 5, w = F.wave;
    const unsigned lo8 = (unsigned)lane * 8u, lo16 = (unsigned)lane * 16u;
    constexpr int IMG = 57344, O_W = 0, O_QG = 16384, O_KD = 32768, O_AT = 49152;
    LAS unsigned char* ring = F.lds + RING_OFF;
    const GAS bf16* Wg = (const GAS bf16*)(F.wsb() + WS_GV) + (size_t)bh * SEQ * HD; const GAS bf16* QGg = (const GAS bf16*)(F.wsb() + WS_GQ) + (size_t)bh * SEQ * HD;
    const GAS bf16* KDg = (const GAS bf16*)(F.wsb() + WS_GK) + (size_t)bh * SEQ * HD; const GAS bf16* ATg = (const GAS bf16*)(F.wsb() + WS_ATT) + (size_t)bh * 32 * 4096;
    __syncthreads();
    if (w >= 4) {
        const int ld = w - 4;
#pragma unroll 1
        for (int c = -1; c < 32; ++c) {
            if (c + 1 < 32) { const int cn = c + 1; LAS unsigned char* img = ring + (cn & 1) * IMG;
                v4u rw[4], rq[4], rk[4], ra[2];
#pragma unroll
                for (int i = 0; i < 4; ++i) { rw[i] = *(const GAS v4u*)(Wg + (size_t)cn * 64 * HD + (4 * ld + i) * 512 + lo8); rq[i] = *(const GAS v4u*)(QGg + (size_t)cn * 64 * HD + (4 * ld + i) * 512 + lo8);
                    rk[i] = *(const GAS v4u*)(KDg + (size_t)cn * 64 * HD + (4 * ld + i) * 512 + lo8); }
#pragma unroll
                for (int i = 0; i < 2; ++i) ra[i] = *(const GAS v4u*)(ATg + (size_t)cn * 4096 + (2 * ld + i) * 512 + lo8);
#pragma unroll
                for (int i = 0; i < 4; ++i) { *(LAS v4u*)(img + O_W + (4 * ld + i) * 1024 + lo16) = rw[i]; *(LAS v4u*)(img + O_QG + (4 * ld + i) * 1024 + lo16) = rq[i]; *(LAS v4u*)(img + O_KD + (4 * ld + i) * 1024 + lo16) = rk[i]; }
#pragma unroll
                for (int i = 0; i < 2; ++i) *(LAS v4u*)(img + O_AT + (2 * ld + i) * 1024 + lo16) = ra[i];
            }
            __syncthreads();
        }
    } else {
        const int es = w, b = bh / GH, h = bh % GH;
        f32x16 S[4];
#pragma unroll
        for (int db = 0; db < 4; ++db) S[db] = (f32x16){};
        GAS bf16* GOb = (GAS bf16*)(F.wsb() + WS_GO) + (size_t)b * SEQ * 768 + h * HD + 32 * es + r32;
        const GAS bf16* GUg = (const GAS bf16*)(F.wsb() + WS_GU) + (size_t)bh * 32 * 8192 + es * 2048; const GAS float* EG = (const GAS float*)(F.wsb() + WS_EGL) + bh * 32;
        v4u g0a = *(const GAS v4u*)(GUg + lo16), g0b = *(const GAS v4u*)(GUg + lo16 + 8), g1a = *(const GAS v4u*)(GUg + 1024 + lo16), g1b = *(const GAS v4u*)(GUg + 1024 + lo16 + 8);
        float eg = EG[0];
        __syncthreads();
#pragma unroll 1
        for (int ch = 0; ch < 32; ++ch) {
            const LAS bf16* img = (const LAS bf16*)(ring + (ch & 1) * IMG);
            const LAS bf16* Wl = img + O_W / 2 + lo8; const LAS bf16* QGl = img + O_QG / 2 + lo8; const LAS bf16* KDl = img + O_KD / 2 + lo8; const LAS bf16* ATl = img + O_AT / 2 + lo8;
            bf16x8 Sb[4][2];
#pragma unroll
            for (int db = 0; db < 4; ++db) { Sb[db][0] = pack8f(S[db][0], S[db][1], S[db][2], S[db][3], S[db][4], S[db][5], S[db][6], S[db][7]); Sb[db][1] = pack8f(S[db][8], S[db][9], S[db][10], S[db][11], S[db][12], S[db][13], S[db][14], S[db][15]); }
            f32x16 VN[2], OT[2];
#pragma unroll
            for (int i = 0; i < 4; ++i) { VN[0][2 * i] = bflo(g0a[i]); VN[0][2 * i + 1] = bfhi(g0a[i]); VN[0][8 + 2 * i] = bflo(g0b[i]); VN[0][8 + 2 * i + 1] = bfhi(g0b[i]);
                VN[1][2 * i] = bflo(g1a[i]); VN[1][2 * i + 1] = bfhi(g1a[i]); VN[1][8 + 2 * i] = bflo(g1b[i]); VN[1][8 + 2 * i + 1] = bfhi(g1b[i]); }
            const float egc = eg;
            if (ch + 1 < 32) { const GAS bf16* GUn = GUg + (size_t)(ch + 1) * 8192;
                g0a = *(const GAS v4u*)(GUn + lo16); g0b = *(const GAS v4u*)(GUn + lo16 + 8); g1a = *(const GAS v4u*)(GUn + 1024 + lo16); g1b = *(const GAS v4u*)(GUn + 1024 + lo16 + 8); eg = EG[ch + 1]; }
#pragma unroll
            for (int rb = 0; rb < 2; ++rb)
#pragma unroll
                for (int i = 0; i < 8; ++i) VN[rb] = MFMA32(*(const LAS bf16x8*)(Wl + (rb * 8 + i) * 512), Sb[i >> 1][i & 1], VN[rb]);
            bf16x8 VNb[2][2];
#pragma unroll
            for (int cb = 0; cb < 2; ++cb) { VNb[cb][0] = pack8f(VN[cb][0], VN[cb][1], VN[cb][2], VN[cb][3], VN[cb][4], VN[cb][5], VN[cb][6], VN[cb][7]); VNb[cb][1] = pack8f(VN[cb][8], VN[cb][9], VN[cb][10], VN[cb][11], VN[cb][12], VN[cb][13], VN[cb][14], VN[cb][15]); }
#pragma unroll
            for (int db = 0; db < 4; ++db) { S[db] = S[db] * egc;
#pragma unroll
                for (int j = 0; j < 4; ++j) S[db] = MFMA32(*(const LAS bf16x8*)(KDl + (db * 4 + j) * 512), VNb[j >> 1][j & 1], S[db]); }
#pragma unroll
            for (int rb = 0; rb < 2; ++rb) { OT[rb] = (f32x16){};
#pragma unroll
                for (int i = 0; i < 8; ++i) OT[rb] = MFMA32(*(const LAS bf16x8*)(QGl + (rb * 8 + i) * 512), Sb[i >> 1][i & 1], OT[rb]);
#pragma unroll
                for (int j = 0; j < 4; ++j) OT[rb] = MFMA32(*(const LAS bf16x8*)(ATl + (rb * 4 + j) * 512), VNb[j >> 1][j & 1], OT[rb]);
#pragma unroll
                for (int r = 0; r < 16; ++r) { const float v = OT[rb][r]; const float vn = xl1(v);
                    if ((r32 & 1) == 0) *(GAS unsigned*)(GOb + (size_t)(ch * 64 + 32 * rb + crow(r, hi)) * 768) = pk2(v, vn); } }
            __syncthreads();
        }
    }
}
__device__ __forceinline__ void ph_fill(Frame& F, int l, int first, int stride) {
    const int lane = F.lane();
    const GAS bf16* P = (const GAS bf16*)(F.wsb() + WS_PROJ);
    {
        GAS bf16* KN = (GAS bf16*)(F.wsb() + WS_KN);
        for (int it = first; it < NBATCH * (SEQ / 8); it += stride) {
            const int tb = it % (SEQ / 8), b = it / (SEQ / 8), t0 = tb * 8; const size_t m0 = (size_t)b * SEQ + t0;
            unsigned raw[8][4];
#pragma unroll
            for (int i = 0; i < 8; ++i)
#pragma unroll
                for (int q = 0; q < 4; ++q) raw[i][q] = *(const GAS unsigned*)(P + (m0 + i) * NPROJ + PC_NKV + (2 + 2 * (q >> 1)) * 256 + (q & 1) * 128 + 2 * lane);
            float kn[2][2];
#pragma unroll
            for (int w = 0; w < 2; ++w) { const GAS float* kp_ = F.inp(I_NKN) + (size_t)(l * 3 + 1 + w) * HD + 2 * lane; kn[w][0] = kp_[0]; kn[w][1] = kp_[1]; }
#pragma unroll
            for (int i = 0; i < 8; ++i)
#pragma unroll
                for (int q = 0; q < 4; ++q) { const int which = q >> 1, hkv = q & 1; const float a0 = bflo(raw[i][q]), a1 = bfhi(raw[i][q]);
                    const float rs = 1.0f / sqrtf(wave_sum(a0 * a0 + a1 * a1) * (1.f / HD) + RMS_EPS);
                    { const int key = t0 + i, d = 2 * lane;
                      *(GAS unsigned*)(KN + ((size_t)((which * NBATCH + b) * NHKV + hkv) * 64 + (key >> 5)) * 4096 + (((d >> 4) * 64 + (key & 31) + 32 * ((d >> 3) & 1)) * 8 + (d & 7))) = pk2(a0 * rs * kn[which][0], a1 * rs * kn[which][1]); } }
        }
    }
    {
        GAS bf16* Y = (GAS bf16*)(F.wsb() + WS_H);
        const GAS float* sw = F.inp(I_SCW) + (size_t)l * 512 * 3;
        for (int it = first; it < NBATCH * (SEQ / 8); it += stride) {
            const int tb = it % (SEQ / 8), b = it / (SEQ / 8), t0 = tb * 8; const size_t m0 = (size_t)b * SEQ + t0; const int c0 = 8 * lane;
            v4u ru[10], rc[10], rb[8];
#pragma unroll
            for (int j = 0; j < 10; ++j) { const int tt = t0 - 2 + j; if (tt >= 0) { ru[j] = *(const GAS v4u*)(P + (m0 - 2 + j) * NPROJ + PC_CU + c0); rc[j] = *(const GAS v4u*)(P + (m0 - 2 + j) * NPROJ + PC_CC + c0); } else { ru[j] = (v4u){0u, 0u, 0u, 0u}; rc[j] = (v4u){0u, 0u, 0u, 0u}; } }
#pragma unroll
            for (int i = 0; i < 8; ++i) rb[i] = *(const GAS v4u*)(P + (m0 + i) * NPROJ + PC_CB + c0);
            float wv[8][3];
#pragma unroll
            for (int c = 0; c < 8; ++c)
#pragma unroll
                for (int j = 0; j < 3; ++j) wv[c][j] = sw[(c0 + c) * 3 + j];
#pragma unroll
            for (int i = 0; i < 8; ++i) { float acc[8];
#pragma unroll
                for (int c = 0; c < 8; ++c) acc[c] = 0.f;
#pragma unroll
                for (int j = 0; j < 3; ++j)
#pragma unroll
                    for (int q = 0; q < 4; ++q) { acc[2 * q] += bflo(ru[i + j][q]) * bflo(rc[i + j][q]) * wv[2 * q][j]; acc[2 * q + 1] += bfhi(ru[i + j][q]) * bfhi(rc[i + j][q]) * wv[2 * q + 1][j]; }
                v4u o;
#pragma unroll
                for (int q = 0; q < 4; ++q) o[q] = pk2(acc[2 * q] * bflo(rb[i][q]), acc[2 * q + 1] * bfhi(rb[i][q]));
                *(GAS v4u*)(Y + (m0 + i) * DM + 1536 + c0) = o; }
        }
    }
    {
        LAS bf16* tl = (LAS bf16*)(F.lds + RING_OFF + F.wave * 16384);
        GAS bf16* VT = (GAS bf16*)(F.wsb() + WS_VT);
        const int r32 = lane & 31, hi = lane >> 5;
        for (int it = first; it < 2 * NBATCH * NHKV * 64; it += stride) {
            const int tb = it & 63, r1 = it >> 6, hkv = r1 & 1, r2 = r1 >> 1, b = r2 % NBATCH, which = r2 / NBATCH;
            const GAS bf16* src = P + ((size_t)b * SEQ + 32 * tb) * NPROJ + PC_NKV + (3 + 2 * which) * 256 + hkv * 128;
            GAS bf16* dst = VT + ((size_t)((which * NBATCH + b) * NHKV + hkv) * 64 + tb) * 4096;
#pragma unroll
            for (int i = 0; i < 8; ++i) { const int tok = i * 4 + (lane >> 4), ch = lane & 15;
                *(LAS v4u*)(tl + tok * 136 + 8 * ch) = *(const GAS v4u*)(src + (size_t)tok * NPROJ + 8 * ch); }
            LDS_WAIT();
#pragma unroll
            for (int f = 0; f < 8; ++f) { const int db = f >> 1, ks = f & 1; unsigned w[4];
#pragma unroll
                for (int jj = 0; jj < 4; ++jj) { const int j0 = 2 * jj, k0 = 16 * ks + 8 * (j0 >> 2) + 4 * hi + (j0 & 3);
                    w[jj] = (unsigned)tl[k0 * 136 + 32 * db + r32] | ((unsigned)tl[(k0 + 1) * 136 + 32 * db + r32] << 16); }
                v4u o; o.x = w[0]; o.y = w[1]; o.z = w[2]; o.w = w[3];
                *(GAS v4u*)(dst + (f * 64 + lane) * 8) = o; }
            LDS_WAIT();
        }
    }
}

__device__ __forceinline__ void nsa_tables(Frame& F, int l, float& kmax, float& bmax) {
    LAS float* btab2 = (LAS float*)(F.lds + BTAB_OFF);
    for (int i = F.tid(); i < 6 * 132; i += NWAVES * 64) { const int h = i / 132, d = i % 132; btab2[i] = F.inp(I_RELB)[(d < 128 ? (int)T5B[d] : 31) * 6 + h] * LOG2E; }
    for (int i = F.tid(); i < HD; i += NWAVES * 64) ((LAS float*)(F.lds + BTAB_OFF + 3200))[i] = F.inp(I_NQN)[(size_t)l * HD + i];
    const GAS float* kn = F.inp(I_NKN) + (size_t)l * 3 * HD; float km = 0.f, bm = 0.f;
    for (int i = F.lane(); i < 3 * HD; i += 64) km = fmaxf(km, fabsf(kn[i]));
    for (int i = F.lane(); i < 192; i += 64) bm = fmaxf(bm, fabsf(F.inp(I_RELB)[i]));
    kmax = wave_max(km) * 11.313708498984761f; bmax = wave_max(bm);
    __syncthreads();
}
__device__ __forceinline__ void ph_select(Frame& F, int l) {
    float kmax, bmax; nsa_tables(F, l, kmax, bmax);
    const int gw = F.vcu * NWAVES + F.wave, NGW = F.G * NWAVES;
    LAS float* wl = (LAS float*)(F.lds + RING_OFF + F.wave * 16384);
    for (int it = gw; it < NBATCH * GH * 32; it += NGW) gdn_chunk_unit(F, it, wl, (LAS float*)(F.lds + FL_OFF + F.wave * 1024));
    { const int two = NBATCH * GH * 32 - NGW; if (two > 0 && two < NGW) { if (gw >= two) ph_fill(F, l, gw - two, NGW - two); } else ph_fill(F, l, gw, NGW); }
    for (int it = gw; it < NBATCH * NHKV * 64; it += NGW) nsa_select_unit(F, l, it, wl, (const LAS float*)(F.lds + BTAB_OFF), kmax, bmax);
}
__device__ __forceinline__ void ph_mix2(Frame& F, int l) {
    float kmax, bmax; nsa_tables(F, l, kmax, bmax);
    const int bx = (int)blockIdx.x;
    if (bx < 96) gdn_scan_block(F, bx);
    volatile LAS int* tk = (volatile LAS int*)(F.lds + MISC_OFF + 64);
    gu32* qctr = F.ctl + CW_Q + 64 * (8 + l);
    const int home = (bx < 96) ? (255 - bx) : (bx - 96);
#pragma unroll 1
    for (int k = 0;; ++k) {
        int u, g;
        if (k < 2 && bx < 256 && (int)gridDim.x >= 256) { u = home; g = k; }
        else {
            if (F.tid() == 0) tk[0] = (int)__hip_atomic_fetch_add(qctr, 1u, RLX_AGENT);
            __syncthreads();
            const int j = tk[0];
            __syncthreads();
            if ((int)gridDim.x >= 256) { if (j >= 256) break; u = j; g = 2; } else { if (j >= 768) break; u = j / 3; g = j % 3; }
        }
        nsa_attn_block(F, l, u, g, (const LAS float*)(F.lds + BTAB_OFF), kmax, bmax);
    }
}
__device__ __forceinline__ void ph_mix3(Frame& F, int l) {
    const int gw = F.vcu * NWAVES + F.wave, NGW = F.G * NWAVES, lane = F.lane();
    const GAS bf16* P = (const GAS bf16*)(F.wsb() + WS_PROJ); const GAS bf16* GO = (const GAS bf16*)(F.wsb() + WS_GO); GAS bf16* Y = (GAS bf16*)(F.wsb() + WS_H);
    const GAS float* gn = F.inp(I_GNORM) + (size_t)l * HD + 2 * lane;
    for (int it = gw; it < (MTOK / 16) * GH; it += NGW) { const int h = it % GH; const size_t m0 = (size_t)(it / GH) * 16;
        unsigned ow[16], zw[16];
#pragma unroll
        for (int i = 0; i < 16; ++i) { ow[i] = *(const GAS unsigned*)(GO + (m0 + i) * 768 + h * HD + 2 * lane); zw[i] = *(const GAS unsigned*)(P + (m0 + i) * NPROJ + PC_GZ + h * HD + 2 * lane); }
        const float g0 = gn[0], g1 = gn[1];
#pragma unroll
        for (int i = 0; i < 16; ++i) { const float ox = bflo(ow[i]), oy = bfhi(ow[i]);
            const float rs = 1.0f / sqrtf(wave_sum(ox * ox + oy * oy) * (1.f / HD) + RMS_EPS);
            *(GAS unsigned*)(Y + (m0 + i) * DM + h * HD + 2 * lane) = pk2(ox * rs * g0 * pg8::silu_f(bflo(zw[i])), oy * rs * g1 * pg8::silu_f(bfhi(zw[i]))); }
    }
}

struct Args { const GAS float* in[19]; GAS float* out; GAS unsigned char* ws; int l_lo, l_hi, ph_lo, ph_hi; };
__global__ void __launch_bounds__(NWAVES * 64, 2) trunk_fwd(Args args) {
    extern __shared__ __attribute__((aligned(16))) unsigned char lds[];
    Frame F;
    F.lds = (LAS unsigned char*)lds;
    { int w_ = __builtin_amdgcn_readfirstlane((int)threadIdx.x >> 6); asm volatile("" : "+s"(w_)); F.wave = w_; }
    F.G = gridDim.x; { const int bx = blockIdx.x; F.vcu = (F.G % 8 == 0) ? (bx % 8) * (F.G / 8) + bx / 8 : bx; }
    F.kp = (const __attribute__((address_space(4))) unsigned char*)__builtin_amdgcn_kernarg_segment_ptr(); F.ws_ = args.ws; F.ctl = (gu32*)(args.ws + WS_CTL); F.out = args.out;
    for (int u = F.tid(); u < (LDS_BYTES - LDSCTL_OFF) / 4; u += NWAVES * 64) ((LAS unsigned*)(F.lds + LDSCTL_OFF))[u] = 0u;
    __syncthreads();
#if MK_ONE_LAUNCH
    XcdBarrier bar = xcd_barrier_post((GAS unsigned*)(F.ctl + CW_BAR), (volatile LAS unsigned*)(F.lds + MISC_OFF) + 8);
#define GRID_BAR() xcd_barrier(bar, F.tid())
#else
#define GRID_BAR() do {} while (0)
#endif
    GAS bf16* WIN = (GAS bf16*)(F.wsb() + WS_WIN); GAS bf16* WOUT = (GAS bf16*)(F.wsb() + WS_WOUT); GAS bf16* WGU = (GAS bf16*)(F.wsb() + WS_WGU); GAS bf16* WDN = (GAS bf16*)(F.wsb() + WS_WDN);
    GAS bf16* H = (GAS bf16*)(F.wsb() + WS_H); GAS bf16* PROJ = (GAS bf16*)(F.wsb() + WS_PROJ);
    for (int l = args.l_lo; l < args.l_hi; ++l) {
        const GAS float* xin = (l == 0) ? F.inp(I_X) : F.out;
#define IN(k) (args.ph_lo <= (k) && (k) < args.ph_hi)
        if (IN(0)) { ph_convert(F, l); ph_norm(F, xin, F.inp(I_NMIX) + (size_t)l * DM); GRID_BAR(); }
        if (IN(1)) { pg8::Gemm g{H, WIN, MTOK, NPROJ, DM}; pg8::StaticOrder S; S.init(MTOK, NPROJ, F.G, (int)blockIdx.x); pg8::EpiBf16 E{PROJ, NPROJ};
            pg8::gemm_phase<pg8::EpiBf16, pg8::StaticOrder, true, true>(F.lds + RING_OFF, g, S, E, F.wave); GRID_BAR(); }
        if (IN(2)) { ph_mix1(F, l); GRID_BAR(); }
        if (IN(3)) { ph_select(F, l); GRID_BAR(); }
        if (IN(4)) { ph_mix2(F, l); GRID_BAR(); }
        if (IN(5)) { ph_mix3(F, l); GRID_BAR(); }
        if (IN(6)) { pg8::Gemm g{H, WOUT, MTOK, DM, DM}; pg8::StaticOrder S; S.init(MTOK, DM, F.G, (int)blockIdx.x); pg8::EpiResF32 E{xin, F.out, DM};
            pg8::gemm_phase<pg8::EpiResF32, pg8::StaticOrder, true, true>(F.lds + RING_OFF, g, S, E, F.wave); GRID_BAR(); }
        if (IN(7)) { ph_norm(F, F.out, F.inp(I_NFFN) + (size_t)l * DM); GRID_BAR(); }
        if (IN(8)) { pg8::Gemm g{H, WGU, MTOK, NGU, DM}; pg8::StaticOrder S; S.init(MTOK, NGU, F.G, (int)blockIdx.x); pg8::EpiSwiGLU E{PROJ, DFF};
            pg8::gemm_phase<pg8::EpiSwiGLU, pg8::StaticOrder, true, true>(F.lds + RING_OFF, g, S, E, F.wave); GRID_BAR(); }
        if (IN(9)) { pg8::Gemm g{PROJ, WDN, MTOK, DM, DFF}; pg8::StaticOrder S; S.init(MTOK, DM, F.G, (int)blockIdx.x); pg8::EpiResF32 E{F.out, F.out, DM};
            pg8::gemm_phase<pg8::EpiResF32, pg8::StaticOrder, true, true>(F.lds + RING_OFF, g, S, E, F.wave); if (l + 1 < args.l_hi) GRID_BAR(); }
#undef IN
    }
}

extern "C" void kernel_launch(void* const* d_in, const int* in_sizes, int n_in, void* d_out, int out_size, void* d_ws, size_t ws_size, hipStream_t stream) {
    static int grid = 0;
    if (grid == 0) {
        if (n_in != 19 || in_sizes[0] != MTOK * DM || out_size != MTOK * DM || ws_size < WS_END) { fprintf(stderr, "kernel_launch: unexpected shapes (n_in %d, in0 %d, out %d, ws %zu); nothing launched\n", n_in, n_in > 0 ? in_sizes[0] : -1, out_size, ws_size); grid = -1; return; }
        int dev = 0, cus = 0;
        if (hipGetDevice(&dev) != hipSuccess || hipDeviceGetAttribute(&cus, hipDeviceAttributeMultiprocessorCount, dev) != hipSuccess) { grid = -1; return; }
        if (hipFuncSetAttribute((const void*)trunk_fwd, hipFuncAttributeMaxDynamicSharedMemorySize, LDS_BYTES) != hipSuccess) { fprintf(stderr, "kernel_launch: hipFuncSetAttribute failed\n"); grid = -1; return; }
        int per_cu = 0;
        if (hipOccupancyMaxActiveBlocksPerMultiprocessor(&per_cu, (const void*)trunk_fwd, NWAVES * 64, LDS_BYTES) != hipSuccess || per_cu < 1) fprintf(stderr, "kernel_launch: occupancy query reports %d\n", per_cu);
        (void)hipGetLastError();
        grid = cus;
    }
    if (grid < 0) return;
    if (hipMemsetAsync((char*)d_ws + WS_CTL, 0, CTL_ZERO_BYTES, stream) != hipSuccess) return;
    Args a{};
    for (int i = 0; i < 19; ++i) a.in[i] = (const GAS float*)d_in[i];
    a.out = (GAS float*)d_out; a.ws = (GAS unsigned char*)d_ws;
#if MK_ONE_LAUNCH
    a.l_lo = 0; a.l_hi = DEPTH; a.ph_lo = 0; a.ph_hi = NPHASE;
    hipLaunchKernelGGL(trunk_fwd, dim3(grid), dim3(NWAVES * 64), LDS_BYTES, stream, a);
#else
    for (int l = 0; l < DEPTH; ++l)
        for (int ph = 0; ph < NPHASE; ++ph) { a.l_lo = l; a.l_hi = l + 1; a.ph_lo = ph; a.ph_hi = ph + 1;
            hipLaunchKernelGGL(trunk_fwd, dim3(grid), dim3(NWAVES * 64), LDS_BYTES, stream, a); }
#endif
}
```

```cpp
#include <hip/hip_runtime.h>
#include <cstdio>
#include <cstdint>
#define GAS __attribute__((address_space(1)))

#ifndef MK_ONE_LAUNCH
#define MK_ONE_LAUNCH 1
#endif

namespace pg8 {
#define PG8_LAS __attribute__((address_space(3)))
typedef unsigned short bf16_t;
typedef short bf16x8 __attribute__((ext_vector_type(8)));
typedef float f32x4 __attribute__((ext_vector_type(4)));
typedef unsigned u32x4 __attribute__((ext_vector_type(4)));
constexpr int BM = 256, BK = 64, HALF = 128, HTB = HALF * BK * 2, STAGE_BYTES = 8 * HTB, NXCD = 8, WGM = 4;

__host__ __device__ __forceinline__ int lds_byte(int r, int c) { const int st = (r >> 4) * 2 + (c >> 5), rr = r & 15, cc = c & 31, ob = rr * 64 + cc * 2; return st * 1024 + (ob ^ (((ob >> 9) & 1) << 5)); }
__host__ __device__ __forceinline__ void stage_rc(int b, int& R, int& C) { const int st = b / 1024, sb = b % 1024, swz = sb ^ (((sb >> 9) & 1) << 5); R = (st >> 1) * 16 + swz / 64; C = (st & 1) * 32 + (swz % 64) / 2; }
__host__ __device__ __forceinline__ int perm32(int rho) { const int n = rho >> 4, i = rho & 15; return 8 * (i >> 2) + 4 * n + (i & 3); }

struct Unit { int pm, pn; };
struct Gemm { const GAS bf16_t* A; const GAS bf16_t* Bt; int M, N, K; };

struct StaticOrder {
    int nM, nN, nwg, G, c;
    __host__ __device__ void init(int M, int N, int G_, int c_) { nM = M / BM; nN = N / BM; nwg = nM * nN; G = G_; c = c_; }
    __host__ __device__ bool next(int i, Unit& u) const {
        const long L = (long)i * G + c; if (L >= nwg) return false;
        int wgid = (int)L; { const int q = nwg / NXCD, r = nwg % NXCD, xcd = wgid % NXCD, off = wgid / NXCD; wgid = (xcd < r ? xcd * (q + 1) : r * (q + 1) + (xcd - r) * q) + off; }
        const int nig = WGM * nN, gid = wgid / nig, fm = gid * WGM, gsz = (nM - fm) < WGM ? (nM - fm) : WGM;
        u.pm = fm + ((wgid % nig) % gsz); u.pn = (wgid % nig) / gsz; return true;
    }
    __device__ __forceinline__ void a_ready(const Unit&) const {}
    __device__ __forceinline__ void done(const Unit&) const {}
};

__device__ __forceinline__ unsigned cvt_pk_bf16(float lo, float hi) { unsigned r; asm volatile("v_cvt_pk_bf16_f32 %0, %1, %2" : "=v"(r) : "v"(lo), "v"(hi)); return r; }

struct EpiBf16 {
    static constexpr bool PERM = true, AFTER_DRAIN = false;
    GAS bf16_t* O; int ldc;
    __device__ __forceinline__ void operator()(const f32x4 (&acc)[2][2][4][2], const Unit& u, int wr, int wc, int fr, int fq) const {
        const int row0 = u.pm * BM + wr * 64 + fr; const int col0 = u.pn * BM + wc * 32 + 8 * fq;
#pragma unroll
        for (int ai = 0; ai < 2; ++ai)
#pragma unroll
            for (int m = 0; m < 4; ++m) { GAS bf16_t* rowp = O + (size_t)(row0 + ai * HALF + m * 16) * ldc + col0;
#pragma unroll
                for (int bj = 0; bj < 2; ++bj) { const f32x4 v0 = acc[ai][bj][m][0], v1 = acc[ai][bj][m][1];
                    u32x4 w; w.x = cvt_pk_bf16(v0[0], v0[1]); w.y = cvt_pk_bf16(v0[2], v0[3]); w.z = cvt_pk_bf16(v1[0], v1[1]); w.w = cvt_pk_bf16(v1[2], v1[3]);
                    *(GAS u32x4*)(rowp + bj * HALF) = w; } }
    }
};
struct EpiResF32 {
    static constexpr bool PERM = false, AFTER_DRAIN = false;
    const GAS float* base; GAS float* out; int ldc;
    __device__ __forceinline__ void operator()(const f32x4 (&acc)[2][2][4][2], const Unit& u, int wr, int wc, int fr, int fq) const {
        const int row0 = u.pm * BM + wr * 64 + fr, col0 = u.pn * BM + wc * 32 + 4 * fq;
#pragma unroll
        for (int ai = 0; ai < 2; ++ai)
#pragma unroll
            for (int m = 0; m < 4; ++m) { const size_t off = (size_t)(row0 + ai * HALF + m * 16) * ldc + col0;
#pragma unroll
                for (int bj = 0; bj < 2; ++bj)
#pragma unroll
                    for (int n = 0; n < 2; ++n) { const f32x4 b = *(const GAS f32x4*)(base + off + bj * HALF + n * 16); *(GAS f32x4*)(out + off + bj * HALF + n * 16) = b + acc[ai][bj][m][n]; } }
    }
};
__device__ __forceinline__ float silu_f(float x) { return x * __builtin_amdgcn_rcpf(1.0f + __expf(-x)); }
struct EpiSwiGLU {
    static constexpr bool PERM = true, AFTER_DRAIN = false;
    GAS bf16_t* O; int ldc;
    __device__ __forceinline__ void operator()(const f32x4 (&acc)[2][2][4][2], const Unit& u, int wr, int wc, int fr, int fq) const {
        const int row0 = u.pm * BM + wr * 64 + fr; const int col0 = u.pn * HALF + wc * 32 + 8 * fq;
#pragma unroll
        for (int ai = 0; ai < 2; ++ai)
#pragma unroll
            for (int m = 0; m < 4; ++m) { GAS bf16_t* rowp = O + (size_t)(row0 + ai * HALF + m * 16) * ldc + col0;
                const f32x4 g0 = acc[ai][0][m][0], g1 = acc[ai][0][m][1], u0 = acc[ai][1][m][0], u1 = acc[ai][1][m][1];
                float r[8];
#pragma unroll
                for (int j = 0; j < 4; ++j) { r[j] = silu_f(g0[j]) * u0[j]; r[4 + j] = silu_f(g1[j]) * u1[j]; }
                u32x4 w; w.x = cvt_pk_bf16(r[0], r[1]); w.y = cvt_pk_bf16(r[2], r[3]); w.z = cvt_pk_bf16(r[4], r[5]); w.w = cvt_pk_bf16(r[6], r[7]);
                *(GAS u32x4*)rowp = w; }
    }
};

template <class Epi, class Sched, bool ALIGN_EPI = false, bool SP2 = false>
__device__ __forceinline__ void gemm_phase(PG8_LAS unsigned char* lds, const Gemm g, const Sched& S, const Epi& E, int wave_id) {
    int tid_; asm volatile("v_mbcnt_lo_u32_b32 %0, -1, 0\n\tv_mbcnt_hi_u32_b32 %0, -1, %0" : "=v"(tid_)); tid_ += wave_id * 64;
    const int tid = tid_, wid = __builtin_amdgcn_readfirstlane(tid >> 6), lane = tid & 63, wr = wid >> 2, wc = wid & 3, fr = lane & 15, fq = lane >> 4;
    const int K = g.K, nt = K / BK;
    unsigned voffA[2], voffB[2];
#pragma unroll
    for (int i = 0; i < 2; ++i) { int R, C; stage_rc(tid * 16 + i * 8192, R, C); const int Rb = Epi::PERM ? ((R & ~31) + perm32(R & 31)) : R;
        voffA[i] = (unsigned)(R * K + C) * 2u; voffB[i] = (unsigned)(Rb * K + C) * 2u; }
    const size_t kstep = (size_t)(BK * 2);
    const size_t hstep = (size_t)HALF * K * 2;
    const size_t tstep = 2 * hstep;
    const unsigned ldsw = (unsigned)wid * 1024u;
    const int aoff = lds_byte(wr * 64 + fr, fq * 8), boff = lds_byte(wc * 32 + fr, fq * 8);
#define PG8_SA(b, h) (((b) * 2 + (h)) * HTB)
#define PG8_SB(b, h) ((4 + (b) * 2 + (h)) * HTB)
#define PG8_STAGE(bufoff, gbase, voff) do { _Pragma("unroll") for (int _i = 0; _i < 2; ++_i) \
        __builtin_amdgcn_global_load_lds((const GAS unsigned*)((const GAS char*)(gbase) + (voff)[_i]), (PG8_LAS unsigned*)(lds + (bufoff) + ldsw + _i * 8192), 16, 0, 0); } while (0)
#define PG8_LDA(dst, b, h) do { _Pragma("unroll") for (int m = 0; m < 4; ++m) _Pragma("unroll") for (int k = 0; k < 2; ++k) dst[m][k] = *(const PG8_LAS bf16x8*)(lds + PG8_SA(b, h) + aoff + m * 2048 + k * 1024); } while (0)
#define PG8_LDB(dst, b, h) do { _Pragma("unroll") for (int n = 0; n < 2; ++n) _Pragma("unroll") for (int k = 0; k < 2; ++k) dst[n][k] = *(const PG8_LAS bf16x8*)(lds + PG8_SB(b, h) + boff + n * 2048 + k * 1024); } while (0)
#define PG8_MMA(ai, bj, At, Bt) do { __builtin_amdgcn_s_setprio(1); _Pragma("unroll") for (int m = 0; m < 4; ++m) _Pragma("unroll") for (int n = 0; n < 2; ++n) _Pragma("unroll") for (int k = 0; k < 2; ++k) \
        acc[ai][bj][m][n] = __builtin_amdgcn_mfma_f32_16x16x32_bf16(Bt[n][k], At[m][k], acc[ai][bj][m][n], 0, 0, 0); __builtin_amdgcn_s_setprio(0); } while (0)
#define PG8_WAIT_V(n) asm volatile("s_waitcnt vmcnt(" #n ")" ::: "memory")
#define PG8_WAIT_L(n) asm volatile("s_waitcnt lgkmcnt(" #n ")" ::: "memory")
#define PG8_BAR __builtin_amdgcn_s_barrier()
#define PG8_SCHED __builtin_amdgcn_sched_barrier(0)
    Unit cur, nxt; int ui = 0;
    if (!S.next(0, cur)) return;
    f32x4 acc[2][2][4][2];
#pragma unroll
    for (int a = 0; a < 2; ++a)
#pragma unroll
        for (int b = 0; b < 2; ++b)
#pragma unroll
            for (int m = 0; m < 4; ++m)
#pragma unroll
                for (int n = 0; n < 2; ++n) acc[a][b][m][n] = (f32x4){0.f, 0.f, 0.f, 0.f};
    bf16x8 At[4][2], B0[2][2], B1[2][2];
    const GAS char* cA = (const GAS char*)g.A + (size_t)cur.pm * tstep; const GAS char* cB = (const GAS char*)g.Bt + (size_t)cur.pn * tstep;
    S.a_ready(cur);
    if constexpr (SP2) {
        PG8_STAGE(PG8_SB(0, 0), cB, voffB); PG8_STAGE(PG8_SB(0, 1), cB + hstep, voffB); PG8_STAGE(PG8_SA(0, 0), cA, voffA); PG8_STAGE(PG8_SA(0, 1), cA + hstep, voffA);
        if (wr == 1) PG8_BAR;
        PG8_WAIT_V(2); PG8_BAR;
        PG8_STAGE(PG8_SB(1, 0), cB + kstep, voffB); PG8_STAGE(PG8_SA(1, 0), cA + kstep, voffA); PG8_STAGE(PG8_SB(1, 1), cB + hstep + kstep, voffB);
        PG8_WAIT_V(6); PG8_BAR;
    } else {
        PG8_STAGE(PG8_SB(0, 0), cB, voffB); PG8_STAGE(PG8_SA(0, 0), cA, voffA); PG8_STAGE(PG8_SB(0, 1), cB + hstep, voffB); PG8_STAGE(PG8_SA(0, 1), cA + hstep, voffA);
        if (wr == 1) PG8_BAR;
        PG8_WAIT_V(4); PG8_BAR;
        PG8_STAGE(PG8_SB(1, 0), cB + kstep, voffB); PG8_STAGE(PG8_SA(1, 0), cA + kstep, voffA); PG8_STAGE(PG8_SB(1, 1), cB + hstep + kstep, voffB);
        PG8_WAIT_V(6); PG8_BAR;
    }
    for (;;) {
        const bool has_next = S.next(ui + 1, nxt);
        const GAS char* nA = has_next ? (const GAS char*)g.A + (size_t)nxt.pm * tstep : cA; const GAS char* nB = has_next ? (const GAS char*)g.Bt + (size_t)nxt.pn * tstep : cB;
        for (int t = 0; t < nt; t += 2) {
            const bool last = (t == nt - 2);
            const GAS char* a1 = cA + (size_t)(t + 1) * kstep;
            const GAS char* a2 = last ? nA : cA + (size_t)(t + 2) * kstep; const GAS char* b2 = last ? nB : cB + (size_t)(t + 2) * kstep;
            const GAS char* a3 = a2 + kstep; const GAS char* b3 = b2 + kstep;
            if (last && has_next) S.a_ready(nxt);
            if constexpr (SP2) {
            PG8_LDB(B0, 0, 0); PG8_LDB(B1, 0, 1); PG8_SCHED; PG8_LDA(At, 0, 0); PG8_STAGE(PG8_SA(1, 1), a1 + hstep, voffA);
            PG8_WAIT_V(8); PG8_WAIT_L(0); PG8_BAR; PG8_MMA(0, 0, At, B0); PG8_MMA(0, 1, At, B1); PG8_BAR; PG8_SCHED;
            PG8_LDA(At, 0, 1); PG8_STAGE(PG8_SB(0, 0), b2, voffB); PG8_STAGE(PG8_SB(0, 1), b2 + hstep, voffB); PG8_STAGE(PG8_SA(0, 0), a2, voffA);
            PG8_WAIT_V(8); PG8_WAIT_L(0); PG8_BAR; PG8_MMA(1, 0, At, B0); PG8_MMA(1, 1, At, B1); PG8_BAR; PG8_SCHED;
            PG8_LDB(B0, 1, 0); PG8_LDB(B1, 1, 1); PG8_SCHED; PG8_LDA(At, 1, 0); PG8_STAGE(PG8_SA(0, 1), a2 + hstep, voffA);
            PG8_WAIT_V(8); PG8_WAIT_L(0); PG8_BAR; PG8_MMA(0, 0, At, B0); PG8_MMA(0, 1, At, B1); PG8_BAR; PG8_SCHED;
            PG8_LDA(At, 1, 1); PG8_STAGE(PG8_SB(1, 0), b3, voffB); PG8_STAGE(PG8_SB(1, 1), b3 + hstep, voffB); PG8_STAGE(PG8_SA(1, 0), a3, voffA);
            PG8_WAIT_V(8); PG8_WAIT_L(0); PG8_BAR; PG8_MMA(1, 0, At, B0); PG8_MMA(1, 1, At, B1); PG8_BAR; PG8_SCHED;
            } else {
            PG8_LDB(B0, 0, 0); PG8_SCHED; PG8_LDA(At, 0, 0); PG8_STAGE(PG8_SA(1, 1), a1 + hstep, voffA);
            PG8_WAIT_L(8); PG8_BAR; PG8_WAIT_L(0); PG8_MMA(0, 0, At, B0); PG8_BAR; PG8_SCHED;
            PG8_LDB(B1, 0, 1); PG8_STAGE(PG8_SB(0, 0), b2, voffB);
            PG8_BAR; PG8_WAIT_L(0); PG8_MMA(0, 1, At, B1); PG8_BAR;
            PG8_LDA(At, 0, 1); PG8_STAGE(PG8_SA(0, 0), a2, voffA);
            PG8_BAR; PG8_WAIT_L(0); PG8_MMA(1, 0, At, B0); PG8_BAR; PG8_SCHED;
            PG8_STAGE(PG8_SB(0, 1), b2 + hstep, voffB);
            PG8_WAIT_V(6); PG8_BAR; PG8_MMA(1, 1, At, B1); PG8_BAR;
            PG8_LDB(B0, 1, 0); PG8_SCHED; PG8_LDA(At, 1, 0); PG8_STAGE(PG8_SA(0, 1), a2 + hstep, voffA);
            PG8_WAIT_L(8); PG8_BAR; PG8_WAIT_L(0); PG8_MMA(0, 0, At, B0); PG8_BAR; PG8_SCHED;
            PG8_LDB(B1, 1, 1); PG8_STAGE(PG8_SB(1, 0), b3, voffB);
            PG8_BAR; PG8_WAIT_L(0); PG8_MMA(0, 1, At, B1); PG8_BAR;
            PG8_LDA(At, 1, 1); PG8_STAGE(PG8_SA(1, 0), a3, voffA);
            PG8_BAR; PG8_WAIT_L(0); PG8_MMA(1, 0, At, B0); PG8_BAR; PG8_SCHED;
            PG8_STAGE(PG8_SB(1, 1), b3 + hstep, voffB);
            PG8_WAIT_V(6); PG8_BAR; PG8_MMA(1, 1, At, B1); PG8_BAR;
            }
        }
        if constexpr (ALIGN_EPI) { if (wr == 0) PG8_BAR; }
        if constexpr (!Epi::AFTER_DRAIN) { E(acc, cur, wr, wc, fr, fq); S.done(cur); }
        if (!has_next) break;
#pragma unroll
        for (int a = 0; a < 2; ++a)
#pragma unroll
            for (int b = 0; b < 2; ++b)
#pragma unroll
                for (int m = 0; m < 4; ++m)
#pragma unroll
                    for (int n = 0; n < 2; ++n) acc[a][b][m][n] = (f32x4){0.f, 0.f, 0.f, 0.f};
        cur = nxt; cA = nA; cB = nB; ++ui;
        if constexpr (ALIGN_EPI) { if (wr == 1) PG8_BAR; }
    }
    PG8_WAIT_V(0);
    if constexpr (!ALIGN_EPI) { if (wr == 0) PG8_BAR; }
    PG8_BAR;
#undef PG8_SA
#undef PG8_SB
#undef PG8_STAGE
#undef PG8_LDA
#undef PG8_LDB
#undef PG8_MMA
#undef PG8_WAIT_V
#undef PG8_WAIT_L
#undef PG8_BAR
#undef PG8_SCHED
}
}

constexpr int NWAVES = 8;
constexpr int DM = 2048, NBATCH = 16, SEQ = 2048, MTOK = NBATCH * SEQ, DEPTH = 4;
constexpr int NPROJ = 7168, PROJ_ORIG = 6942, DFF = 5632, NGU = 2 * DFF;
constexpr int GH = 6, HD = 128, NHKV = 2, NCMP = 127;
constexpr int PC_GQKV = 0, PC_GZ = 2304, PC_NQ = 3072, PC_NKV = 3840, PC_CU = 5376, PC_CB = 5888, PC_CC = 6400, PC_GB = 6912, PC_GA = 6918, PC_NG = 6924;
constexpr float RMS_EPS = 1e-6f;
constexpr int NPHASE = 10;

constexpr size_t MiB = 1u << 20;
constexpr size_t WS_CTL = 0, CTL_ZERO_BYTES = 1 * MiB;
constexpr size_t WS_WIN = 2 * MiB, WS_WOUT = 30 * MiB, WS_WGU = 38 * MiB, WS_WDN = 82 * MiB;
constexpr size_t WS_H = 104 * MiB;
constexpr size_t WS_PROJ = 232 * MiB;
constexpr size_t WS_GQ = 680 * MiB, WS_GK = 728 * MiB, WS_GV = 776 * MiB;
constexpr size_t WS_GO = 824 * MiB;
constexpr size_t WS_GU = 872 * MiB;
constexpr size_t WS_ATT = 994 * MiB;
constexpr size_t WS_EGL = 1018 * MiB;
constexpr size_t WS_KN = 920 * MiB;
constexpr size_t WS_KCB = 952 * MiB;
constexpr size_t WS_VCT = 953 * MiB;
constexpr size_t WS_GBG = 956 * MiB;
constexpr size_t WS_VT = 958 * MiB;
constexpr size_t WS_W1T = 990 * MiB;
constexpr size_t WS_W2T = 992 * MiB;
constexpr size_t WS_CBP = 992 * MiB + 131072;
constexpr size_t WS_SEL = 993 * MiB;
constexpr size_t WS_END = 1019 * MiB;
constexpr int CW_TMO = 0, CW_BAR = 4096, CW_Q = 16384;

constexpr int RING_OFF = 0, RING_BYTES = 131072;
constexpr int LDSCTL_OFF = RING_BYTES, MISC_OFF = LDSCTL_OFF + 320, BTAB_OFF = LDSCTL_OFF + 1024, FL_OFF = LDSCTL_OFF + 8192;
constexpr int LDS_BYTES = 147456;

#define LAS __attribute__((address_space(3)))
typedef unsigned short bf16;
typedef unsigned v4u __attribute__((ext_vector_type(4)));
typedef unsigned v2u __attribute__((ext_vector_type(2)));
typedef float f32x4 __attribute__((ext_vector_type(4)));
typedef GAS unsigned gu32;
#define RLX_AGENT __ATOMIC_RELAXED, __HIP_MEMORY_SCOPE_AGENT
#define LDS_WAIT() asm volatile("s_waitcnt lgkmcnt(0)" ::: "memory")
__device__ __forceinline__ unsigned f2bf(float f) { unsigned u = __builtin_bit_cast(unsigned, f); return (u + 0x7fffu + ((u >> 16) & 1u)) >> 16; }
__device__ __forceinline__ unsigned pk2(float lo, float hi) { return f2bf(lo) | (f2bf(hi) << 16); }
__device__ __forceinline__ float bflo(unsigned w) { return __uint_as_float(w << 16); }
__device__ __forceinline__ float bfhi(unsigned w) { return __uint_as_float(w & 0xffff0000u); }
__device__ __forceinline__ float bf2f(bf16 b) { return __uint_as_float(((unsigned)b) << 16); }
__device__ __forceinline__ float xl1(float v) { return __int_as_float(__builtin_amdgcn_update_dpp(0, __float_as_int(v), 0xB1, 0xf, 0xf, false)); }
__device__ __forceinline__ float xl2(float v) { return __int_as_float(__builtin_amdgcn_update_dpp(0, __float_as_int(v), 0x4E, 0xf, 0xf, false)); }
__device__ __forceinline__ float xl7(float v) { return __int_as_float(__builtin_amdgcn_update_dpp(0, __float_as_int(v), 0x141, 0xf, 0xf, false)); }
__device__ __forceinline__ float xl15(float v) { return __int_as_float(__builtin_amdgcn_update_dpp(0, __float_as_int(v), 0x140, 0xf, 0xf, false)); }
__device__ __forceinline__ float xl16(float v) { return __int_as_float(__builtin_amdgcn_ds_swizzle(__float_as_int(v), 0x401F)); }
__device__ __forceinline__ float sum32(float v) { auto r = __builtin_amdgcn_permlane32_swap(__float_as_uint(v), __float_as_uint(v), false, false); return __uint_as_float(r[0]) + __uint_as_float(r[1]); }
__device__ __forceinline__ float max32(float v) { auto r = __builtin_amdgcn_permlane32_swap(__float_as_uint(v), __float_as_uint(v), false, false); return fmaxf(__uint_as_float(r[0]), __uint_as_float(r[1])); }
__device__ __forceinline__ unsigned or32(unsigned v) { auto r = __builtin_amdgcn_permlane32_swap(v, v, false, false); return r[0] | r[1]; }
__device__ __forceinline__ float wave_sum(float v) { v += xl1(v); v += xl2(v); v += xl7(v); v += xl15(v); v += xl16(v); return sum32(v); }
__device__ __forceinline__ float wave_max(float v) { v = fmaxf(v, xl1(v)); v = fmaxf(v, xl2(v)); v = fmaxf(v, xl7(v)); v = fmaxf(v, xl15(v)); v = fmaxf(v, xl16(v)); return max32(v); }
__device__ __forceinline__ unsigned wave_or(unsigned v) { v |= __float_as_uint(xl1(__uint_as_float(v))); v |= __float_as_uint(xl2(__uint_as_float(v))); v |= __float_as_uint(xl7(__uint_as_float(v))); v |= __float_as_uint(xl15(__uint_as_float(v))); v |= __float_as_uint(xl16(__uint_as_float(v))); return or32(v); }
__device__ __forceinline__ int lane_id() { return (int)__builtin_amdgcn_mbcnt_hi(~0u, __builtin_amdgcn_mbcnt_lo(~0u, 0u)); }
__device__ __forceinline__ float sigmoid_f(float x) { return 1.0f / (1.0f + __expf(-x)); }
__device__ __forceinline__ float rl(float v, int l) { return __int_as_float(__builtin_amdgcn_readlane(__float_as_int(v), l)); }

__constant__ unsigned char T5B[128] = {0, 1, 2, 3, 4, 5, 6, 7, 8, 9, 10, 11, 12, 13, 14, 15, 16, 16, 16, 17, 17, 18, 18, 18, 19, 19, 19, 20, 20, 20, 20, 21, 21, 21, 21, 22, 22, 22, 22, 22, 23, 23, 23, 23, 23, 23, 24, 24, 24, 24, 24, 24, 25, 25, 25, 25, 25, 25, 25, 26, 26, 26, 26, 26, 26, 26, 26, 27, 27, 27, 27, 27, 27, 27, 27, 27, 27, 28, 28, 28, 28, 28, 28, 28, 28, 28, 28, 29, 29, 29, 29, 29, 29, 29, 29, 29, 29, 29, 29, 30, 30, 30, 30, 30, 30, 30, 30, 30, 30, 30, 30, 30, 30, 31, 31, 31, 31, 31, 31, 31, 31, 31, 31, 31, 31, 31, 31, 31};

#define XB_TMO      128
#define XB_XCNT(j)  (256  + 64 * (j))
#define XB_XSUB(j)  (1280 + 64 * (j))
#define XB_XGEN(j)  (2304 + 64 * (j))
#define XB_TOP      3328
#define XB_TOPGEN   3392
#define XCD_BAR_WORDS 3456
#define XB_SPIN_CAP (1u << 22)
__device__ __forceinline__ unsigned xb_ld(GAS unsigned* p)              { return __hip_atomic_load(p, __ATOMIC_RELAXED, __HIP_MEMORY_SCOPE_AGENT); }
__device__ __forceinline__ unsigned xb_add(GAS unsigned* p, unsigned v) { return __hip_atomic_fetch_add(p, v, __ATOMIC_RELAXED, __HIP_MEMORY_SCOPE_AGENT); }
__device__ __forceinline__ unsigned xb_xcc_id() { return (unsigned)__builtin_amdgcn_s_getreg((3 << 11) | 20) & 0xFu; }
#define XB_SPIN(cond, bar) do { unsigned _sp = 0; while (cond) { __builtin_amdgcn_s_sleep(1); \
    if ((++_sp & 255u) == 0u) { if (xb_ld(&(bar)[XB_TMO])) break; if (_sp > XB_SPIN_CAP) { (void)xb_add(&(bar)[XB_TMO], 1u); break; } } } } while (0)
struct XcdBarrier { GAS unsigned* bar; unsigned x; volatile LAS unsigned* st; };
__device__ __forceinline__ XcdBarrier xcd_barrier_post(GAS unsigned* bar, volatile LAS unsigned* st) {
    XcdBarrier b; b.bar = bar; b.x = xb_xcc_id(); b.st = st;
    if (threadIdx.x == 0) (void)xb_add(&bar[XB_XCNT(b.x)], 1u);
    return b;
}
__device__ __forceinline__ void xcd_barrier_complete(GAS unsigned* bar, unsigned x, unsigned& nloc, unsigned& nx) {
    const unsigned G = gridDim.x * gridDim.y * gridDim.z;
    unsigned sum, cnt, mine, sp = 0u;
    for (;;) {
        sum = 0u; cnt = 0u; mine = 0u;
#pragma unroll
        for (unsigned j = 0; j < 16; ++j) { const unsigned c = xb_ld(&bar[XB_XCNT(j)]); sum += c; cnt += (c > 0u) ? 1u : 0u; mine = (j == x) ? c : mine; }
        if (sum == G) break;
        __builtin_amdgcn_s_sleep(1);
        if ((++sp & 255u) == 0u) { if (xb_ld(&bar[XB_TMO])) break; if (sp > XB_SPIN_CAP) { (void)xb_add(&bar[XB_TMO], 1u); break; } }
    }
    nloc = mine > 0u ? mine : 1u; nx = cnt > 0u ? cnt : 1u;
}
__device__ __forceinline__ void xcd_barrier(const XcdBarrier& b, int tid) {
    asm volatile("s_waitcnt vmcnt(0)" ::: "memory");
    __syncthreads();
    if (tid == 0) {
        GAS unsigned* bar = b.bar;
        __builtin_amdgcn_s_waitcnt(0);
        unsigned nloc = b.st[0], nx = b.st[1];
        if (nloc == 0u) { xcd_barrier_complete(bar, b.x, nloc, nx); b.st[0] = nloc; b.st[1] = nx; }
        const unsigned old = xb_add(&bar[XB_XSUB(b.x)], 1u);
        const unsigned gen = old / nloc;
        if (old + 1u == (gen + 1u) * nloc) {
            __builtin_amdgcn_fence(__ATOMIC_RELEASE, "agent");
            asm volatile("s_waitcnt vmcnt(0)" ::: "memory");
            const unsigned og = xb_add(&bar[XB_TOP], 1u);
            const unsigned tg = og / nx;
            if (og + 1u == (tg + 1u) * nx) xb_add(&bar[XB_TOPGEN], 1u);
            else XB_SPIN(xb_ld(&bar[XB_TOPGEN]) == tg, bar);
            __builtin_amdgcn_fence(__ATOMIC_ACQUIRE, "agent");
            xb_add(&bar[XB_XGEN(b.x)], 1u);
            asm volatile("s_waitcnt vmcnt(0)" ::: "memory");
        } else {
            XB_SPIN(xb_ld(&bar[XB_XGEN(b.x)]) == gen, bar);
            __builtin_amdgcn_fence(__ATOMIC_ACQUIRE, "agent");
            asm volatile("s_waitcnt vmcnt(0)" ::: "memory");
        }
    }
    __syncthreads();
}

struct Frame {
    LAS unsigned char* lds;
    gu32* ctl;
    int wave, vcu, G;
    __device__ __forceinline__ int lane() const { int l; asm volatile("v_mbcnt_lo_u32_b32 %0, -1, 0\n\tv_mbcnt_hi_u32_b32 %0, -1, %0" : "=v"(l)); return l; }
    __device__ __forceinline__ int tid() const { return wave * 64 + lane(); }
    const __attribute__((address_space(4))) unsigned char* kp;
    GAS float* out; GAS unsigned char* ws_;
    __device__ __forceinline__ GAS unsigned char* wsb() const { GAS unsigned char* p = ws_; asm volatile("" : "+s"(p)); return p; }
    __device__ __forceinline__ const GAS float* inp(int i) const { const __attribute__((address_space(4))) unsigned char* p = kp; asm volatile("" : "+s"(p)); return ((const GAS float* const __attribute__((address_space(4)))*)p)[i]; }
};
enum { I_X = 0, I_RELB, I_NMIX, I_WIN, I_GCONV, I_GALOG, I_GDT, I_GNORM, I_NQN, I_NKN, I_CPOS, I_CW1, I_CW2, I_SCW, I_WOUT, I_NFFN, I_WG, I_WU, I_WD };

__device__ __forceinline__ void transpose_tile(const GAS float* W, int ldw, int scol, GAS bf16* WTrow0, int K, int k0, LAS float* scr, int lane) {
    float tv[32];
#pragma unroll
    for (int i = 0; i < 32; ++i) { const int kk = 2 * i + (lane >> 5); tv[i] = scol >= 0 ? W[(size_t)(k0 + kk) * ldw + scol] : 0.f; }
#pragma unroll
    for (int i = 0; i < 32; ++i) { const int kk = 2 * i + (lane >> 5); scr[kk * 33 + (lane & 31)] = tv[i]; }
    LDS_WAIT();
    const int c = lane & 7;
#pragma unroll
    for (int j = 0; j < 4; ++j) { const int n = (lane >> 3) + 8 * j; const LAS float* s = scr + (8 * c) * 33 + n;
        v4u o; o.x = pk2(s[0 * 33], s[1 * 33]); o.y = pk2(s[2 * 33], s[3 * 33]); o.z = pk2(s[4 * 33], s[5 * 33]); o.w = pk2(s[6 * 33], s[7 * 33]);
        *(GAS v4u*)(WTrow0 + (size_t)n * K + k0 + 8 * c) = o; }
    LDS_WAIT();
}
__device__ __forceinline__ int win_src(int n) {
    if (n < 3072) return n;
    if (n < 5376) return n + 12;
    if (n < 6912) return n + 30;
    if (n < 6924) return n - 6912 + 3072;
    if (n < 6942) return n - 6924 + 5388;
    return -1;
}
__device__ __forceinline__ void ph_convert(Frame& F, int l) {
    LAS float* scr = (LAS float*)(F.lds + RING_OFF + F.wave * 16384);
    const int gw = F.vcu * NWAVES + F.wave, NGW = F.G * NWAVES, lane = F.lane();
    constexpr int I_A = 32 * (NPROJ / 32), I_B = 32 * (DM / 32), I_C = 32 * (NGU / 32), I_D = (DFF / 64) * (DM / 32);
    GAS bf16* WIN = (GAS bf16*)(F.wsb() + WS_WIN); GAS bf16* WOUT = (GAS bf16*)(F.wsb() + WS_WOUT); GAS bf16* WGU = (GAS bf16*)(F.wsb() + WS_WGU); GAS bf16* WDN = (GAS bf16*)(F.wsb() + WS_WDN);
    for (int it = gw; it < I_A + I_B + I_C + I_D; it += NGW) {
        int r = it;
        if (r < I_A) { const int nblk = NPROJ / 32, kb = r / nblk, nb = r % nblk; const int sc = win_src(nb * 32 + (lane & 31));
            transpose_tile(F.inp(I_WIN) + (size_t)l * DM * PROJ_ORIG, PROJ_ORIG, sc, WIN + (size_t)(nb * 32) * DM, DM, kb * 64, scr, lane); continue; }
        r -= I_A;
        if (r < I_B) { const int nblk = DM / 32, kb = r / nblk, nb = r % nblk;
            transpose_tile(F.inp(I_WOUT) + (size_t)l * DM * DM, DM, nb * 32 + (lane & 31), WOUT + (size_t)(nb * 32) * DM, DM, kb * 64, scr, lane); continue; }
        r -= I_B;
        if (r < I_C) { const int nblk = NGU / 32, kb = r / nblk, nb = r % nblk; const int n0 = nb * 32, pn = n0 >> 8, rr = n0 & 255;
            const GAS float* src = (rr < 128) ? F.inp(I_WG) : F.inp(I_WU);
            transpose_tile(src + (size_t)l * DM * DFF, DFF, pn * 128 + (rr & 127) + (lane & 31), WGU + (size_t)n0 * DM, DM, kb * 64, scr, lane); continue; }
        r -= I_C;
        { const int nblk = DM / 32, kb = r / nblk, nb = r % nblk;
            transpose_tile(F.inp(I_WD) + (size_t)l * DFF * DM, DM, nb * 32 + (lane & 31), WDN + (size_t)(nb * 32) * DFF, DFF, kb * 64, scr, lane); }
    }
    GAS bf16* W1T = (GAS bf16*)(F.wsb() + WS_W1T); GAS bf16* W2T = (GAS bf16*)(F.wsb() + WS_W2T); GAS float* CBP = (GAS float*)(F.wsb() + WS_CBP);
    for (int it = gw; it < 512 + 16 + 32; it += NGW) {
        int r = it;
        if (r < 512) { const int sel = r >> 8, q = r & 255, kb = q >> 2, nb = q & 3;
            transpose_tile(F.inp(I_CW1) + (size_t)(l * 2 + sel) * 4096 * HD, HD, nb * 32 + (lane & 31), W1T + (size_t)(sel * HD + nb * 32) * 4096, 4096, kb * 64, scr, lane); continue; }
        r -= 512;
        if (r < 16) { const int sel = r >> 3, q = r & 7, kb = q >> 2, nb = q & 3;
            transpose_tile(F.inp(I_CW2) + (size_t)(l * 2 + sel) * HD * HD, HD, nb * 32 + (lane & 31), W2T + (size_t)(sel * HD + nb * 32) * HD, HD, kb * 64, scr, lane); continue; }
        r -= 16;
        { const int sel = r >> 4, ch = r & 15; const GAS float* pe = F.inp(I_CPOS) + (size_t)(l * 2 + sel) * 4096 + ch * 256; const GAS float* w1 = F.inp(I_CW1) + ((size_t)(l * 2 + sel) * 4096 + ch * 256) * HD;
            float h0 = 0.f, h1 = 0.f;
            for (int i = 0; i < 256; ++i) { const float a = pe[i]; h0 += a * w1[(size_t)i * HD + lane]; h1 += a * w1[(size_t)i * HD + 64 + lane]; }
            CBP[(sel * 16 + ch) * HD + lane] = h0; CBP[(sel * 16 + ch) * HD + 64 + lane] = h1; }
    }
}
__device__ __forceinline__ void ph_norm(Frame& F, const GAS float* x, const GAS float* gain) {
    const int gw = F.vcu * NWAVES + F.wave, NGW = F.G * NWAVES, lane = F.lane(); GAS bf16* H = (GAS bf16*)(F.wsb() + WS_H);
    const GAS f32x4* gr = (const GAS f32x4*)gain + lane;
    for (int m = 4 * gw; m < MTOK; m += 4 * NGW) {
        f32x4 v[4][8]; float sq[4];
#pragma unroll
        for (int q = 0; q < 4; ++q)
#pragma unroll
            for (int j = 0; j < 8; ++j) v[q][j] = ((const GAS f32x4*)(x + (size_t)(m + q) * DM) + lane)[64 * j];
#pragma unroll
        for (int q = 0; q < 4; ++q) { float a = 0.f;
#pragma unroll
            for (int j = 0; j < 8; ++j) a += (v[q][j].x * v[q][j].x + v[q][j].y * v[q][j].y) + (v[q][j].z * v[q][j].z + v[q][j].w * v[q][j].w);
            sq[q] = 1.0f / sqrtf(wave_sum(a) * (1.f / DM) + RMS_EPS); }
#pragma unroll
        for (int j = 0; j < 8; ++j) { const f32x4 g = gr[64 * j];
#pragma unroll
            for (int q = 0; q < 4; ++q) { v2u w; w.x = pk2(v[q][j].x * sq[q] * g.x, v[q][j].y * sq[q] * g.y); w.y = pk2(v[q][j].z * sq[q] * g.z, v[q][j].w * sq[q] * g.w);
                ((GAS v2u*)(H + (size_t)(m + q) * DM) + lane)[64 * j] = w; } }
    }
}

typedef short bf16x8 __attribute__((ext_vector_type(8)));
typedef short s16x4 __attribute__((ext_vector_type(4)));
typedef float f32x16 __attribute__((ext_vector_type(16)));
__device__ __forceinline__ int crow(int r, int hi) { return (r & 3) + 8 * (r >> 2) + 4 * hi; }
__device__ __forceinline__ bf16x8 ld16(const GAS bf16* p) { return *(const GAS bf16x8*)p; }
__device__ __forceinline__ bf16x8 ld8x2(const GAS bf16* p) { const s16x4 a = *(const GAS s16x4*)p, b = *(const GAS s16x4*)(p + 8); return (bf16x8){a[0], a[1], a[2], a[3], b[0], b[1], b[2], b[3]}; }
__device__ __forceinline__ bf16x8 pack8f(float a0, float a1, float a2, float a3, float a4, float a5, float a6, float a7) {
    v4u w; w.x = pg8::cvt_pk_bf16(a0, a1); w.y = pg8::cvt_pk_bf16(a2, a3); w.z = pg8::cvt_pk_bf16(a4, a5); w.w = pg8::cvt_pk_bf16(a6, a7); return __builtin_bit_cast(bf16x8, w); }
#define MFMA32(a, b, c) __builtin_amdgcn_mfma_f32_32x32x16_bf16((a), (b), (c), 0, 0, 0)
constexpr float LOG2E = 1.4426950408889634f;

__device__ __forceinline__ void cmp_unit(Frame& F, int l, int it) {
    const int lane = F.lane(), r32 = lane & 31, hi = lane >> 5;
    const int nb = it & 3, r1 = it >> 2, hkv = r1 & 1, r2 = r1 >> 1, b = r2 % NBATCH, sel = r2 / NBATCH;
    const int n = 32 * nb + r32;
    const GAS bf16* P = (const GAS bf16*)(F.wsb() + WS_PROJ);
    const GAS bf16* brow = P + ((size_t)b * SEQ + 16 * n) * NPROJ + PC_NKV + sel * 256 + hkv * 128 + 8 * hi;
    const GAS bf16* W1T = (const GAS bf16*)(F.wsb() + WS_W1T) + (size_t)sel * HD * 4096 + (size_t)r32 * 4096 + 8 * hi;
    f32x16 acc[4];
#pragma unroll
    for (int cb = 0; cb < 4; ++cb) acc[cb] = (f32x16){};
#pragma unroll 1
    for (int li = 4 * F.wave; li < 4 * F.wave + 4; ++li) {
        bf16x8 bfr[8];
#pragma unroll
        for (int q = 0; q < 8; ++q) bfr[q] = ld16(brow + (size_t)li * NPROJ + 16 * q);
#pragma unroll
        for (int q2 = 0; q2 < 4; ++q2) { bf16x8 wf[8];
#pragma unroll
            for (int i = 0; i < 8; ++i) wf[i] = ld16(W1T + (size_t)(i & 3) * 32 * 4096 + 16 * (li * 8 + 2 * q2 + (i >> 2)));
#pragma unroll
            for (int i = 0; i < 8; ++i) acc[i & 3] = MFMA32(wf[i], bfr[2 * q2 + (i >> 2)], acc[i & 3]); }
    }
    LAS float* part = (LAS float*)(F.lds + RING_OFF + F.wave * 16384);
#pragma unroll
    for (int cb = 0; cb < 4; ++cb)
#pragma unroll
        for (int r = 0; r < 16; ++r) part[(cb * 16 + r) * 64 + lane] = acc[cb][r];
    LDS_WAIT();
    __syncthreads();
    if (F.wave != 0) { __syncthreads(); return; }
#pragma unroll 1
    for (int w = 1; w < NWAVES; ++w) { const LAS float* pw = (const LAS float*)(F.lds + RING_OFF + w * 16384);
#pragma unroll
        for (int cb = 0; cb < 4; ++cb)
#pragma unroll
            for (int r = 0; r < 16; ++r) acc[cb][r] += pw[(cb * 16 + r) * 64 + lane]; }
    LAS float* bl = (LAS float*)(F.lds + FL_OFF);
    { const GAS float* cbp = (const GAS float*)(F.wsb() + WS_CBP) + (size_t)sel * 16 * HD; float b0 = 0.f, b1 = 0.f;
      for (int ch = 0; ch < 16; ++ch) { b0 += cbp[ch * HD + lane]; b1 += cbp[ch * HD + 64 + lane]; }
      bl[lane] = b0; bl[64 + lane] = b1; }
    LDS_WAIT();
    bf16x8 hb[4][2];
#pragma unroll
    for (int cb = 0; cb < 4; ++cb) { float hv[16];
#pragma unroll
        for (int r = 0; r < 16; ++r) hv[r] = pg8::silu_f(acc[cb][r] + bl[32 * cb + crow(r, hi)]);
        hb[cb][0] = pack8f(hv[0], hv[1], hv[2], hv[3], hv[4], hv[5], hv[6], hv[7]); hb[cb][1] = pack8f(hv[8], hv[9], hv[10], hv[11], hv[12], hv[13], hv[14], hv[15]); }
    LDS_WAIT();
    const GAS bf16* W2T = (const GAS bf16*)(F.wsb() + WS_W2T) + (size_t)sel * HD * HD + (size_t)r32 * HD + 4 * hi;
    f32x16 o2[4];
#pragma unroll
    for (int c2b = 0; c2b < 4; ++c2b) { o2[c2b] = (f32x16){};
        bf16x8 wf[8];
#pragma unroll
        for (int i = 0; i < 8; ++i) wf[i] = ld8x2(W2T + (size_t)c2b * 32 * HD + 32 * (i >> 1) + 16 * (i & 1));
#pragma unroll
        for (int i = 0; i < 8; ++i) o2[c2b] = MFMA32(wf[i], hb[i >> 1][i & 1], o2[c2b]); }
    if (sel == 0) {
        float ss = 0.f;
#pragma unroll
        for (int c2b = 0; c2b < 4; ++c2b)
#pragma unroll
            for (int r = 0; r < 16; ++r) ss += o2[c2b][r] * o2[c2b][r];
        ss = sum32(ss);
        const float rs = 1.0f / sqrtf(ss * (1.f / HD) + RMS_EPS); const GAS float* kn = F.inp(I_NKN) + (size_t)(l * 3) * HD;
        GAS bf16* dst = (GAS bf16*)(F.wsb() + WS_KCB) + ((size_t)(b * NHKV + hkv) * 128 + n) * HD;
#pragma unroll
        for (int c2b = 0; c2b < 4; ++c2b)
#pragma unroll
            for (int g = 0; g < 4; ++g) { const int c2 = 32 * c2b + 8 * g + 4 * hi; const f32x4 gn = *(const GAS f32x4*)(kn + c2);
                v2u w; w.x = pk2(o2[c2b][4 * g] * rs * gn.x, o2[c2b][4 * g + 1] * rs * gn.y); w.y = pk2(o2[c2b][4 * g + 2] * rs * gn.z, o2[c2b][4 * g + 3] * rs * gn.w);
                if (n == 127) { w.x = 0u; w.y = 0u; }
                *(GAS v2u*)(dst + c2) = w; }
    } else {
        GAS bf16* dst = (GAS bf16*)(F.wsb() + WS_VCT) + (size_t)(b * NHKV + hkv) * HD * 128 + n;
#pragma unroll
        for (int c2b = 0; c2b < 4; ++c2b)
#pragma unroll
            for (int r = 0; r < 16; ++r) dst[(size_t)(32 * c2b + crow(r, hi)) * 128] = (n == 127) ? (bf16)0 : (bf16)f2bf(o2[c2b][r]);
    }
    __syncthreads();
}

__device__ __forceinline__ void load_q(const GAS bf16* qrow, const LAS float* qn, int hi, bf16x8 (&qf)[8], float& qnorm) {
    v4u raw[8]; float ss = 0.f;
#pragma unroll
    for (int ks = 0; ks < 8; ++ks) raw[ks] = *(const GAS v4u*)(qrow + 16 * ks + 8 * hi);
    asm volatile("" ::: "memory");
#pragma unroll
    for (int ks = 0; ks < 8; ++ks)
#pragma unroll
        for (int i = 0; i < 4; ++i) { const float a = bflo(raw[ks][i]), b = bfhi(raw[ks][i]); ss += a * a + b * b; }
    ss = sum32(ss);
    const float rs = (1.0f / sqrtf(ss * (1.f / HD) + RMS_EPS)) * 0.08838834764831845f;
    float n2 = 0.f;
#pragma unroll
    for (int ks = 0; ks < 8; ++ks) { const f32x4 g0 = *(const LAS f32x4*)(qn + 16 * ks + 8 * hi), g1 = *(const LAS f32x4*)(qn + 16 * ks + 8 * hi + 4);
        float f[8];
#pragma unroll
        for (int i = 0; i < 4; ++i) { f[2 * i] = bflo(raw[ks][i]) * rs; f[2 * i + 1] = bfhi(raw[ks][i]) * rs; }
        f[0] *= g0.x; f[1] *= g0.y; f[2] *= g0.z; f[3] *= g0.w; f[4] *= g1.x; f[5] *= g1.y; f[6] *= g1.z; f[7] *= g1.w;
#pragma unroll
        for (int i = 0; i < 8; ++i) n2 += f[i] * f[i];
        qf[ks] = pack8f(f[0], f[1], f[2], f[3], f[4], f[5], f[6], f[7]); }
    n2 = sum32(n2);
    qnorm = sqrtf(n2);
}

__device__ __forceinline__ void nsa_select_unit(Frame& F, int l, int item, LAS float* wl, const LAS float* btab2, float kmax, float bmax) {
    const int lane = F.lane(), r32 = lane & 31, hi = lane >> 5;
    const int tt = item & 63, r1 = item >> 6, hkv = r1 & 1, b = r1 >> 1, t = 32 * tt + r32; const size_t m = (size_t)b * SEQ + t;
    const GAS bf16* P = (const GAS bf16*)(F.wsb() + WS_PROJ);
    const GAS bf16* KCB = (const GAS bf16*)(F.wsb() + WS_KCB) + (size_t)(b * NHKV + hkv) * 128 * HD + (size_t)r32 * HD + 8 * hi;
#pragma unroll 1
    for (int g = 0; g < 3; ++g) { const int h = hkv * 3 + g; const LAS float* bt = btab2 + h * 132;
        bf16x8 qf[8]; float qnorm;
        load_q(P + m * NPROJ + PC_NQ + h * HD, (const LAS float*)(F.lds + BTAB_OFF + 3200), hi, qf, qnorm);
        const float shift = -(qnorm * kmax + bmax) * LOG2E;
        f32x16 p[4]; float ls = 0.f;
#pragma unroll
        for (int nb = 0; nb < 4; ++nb) { p[nb] = (f32x16){};
#pragma unroll
            for (int k4 = 0; k4 < 2; ++k4) { bf16x8 kf[4];
#pragma unroll
                for (int ks = 0; ks < 4; ++ks) kf[ks] = ld16(KCB + (size_t)nb * 32 * HD + 16 * (4 * k4 + ks));
#pragma unroll
                for (int ks = 0; ks < 4; ++ks) p[nb] = MFMA32(kf[ks], qf[4 * k4 + ks], p[nb]); }
#pragma unroll
            for (int r = 0; r < 16; ++r) { const int n = 32 * nb + crow(r, hi); const int dist = t - 16 * n - 31; const int di = dist < 0 ? 0 : (dist > 128 ? 128 : dist);
                const float tb = bt[di] + shift; const float ee = __builtin_amdgcn_exp2f(__builtin_fmaf(p[nb][r], LOG2E, tb)); const float e = dist >= 0 ? ee : 0.f; p[nb][r] = e; ls += e; } }
        ls = sum32(ls);
        const float inv = ls > 0.f ? 1.0f / ls : 0.f;
#pragma unroll
        for (int nb = 0; nb < 4; ++nb)
#pragma unroll
            for (int r = 0; r < 16; ++r) { LAS float* w = wl + (32 * nb + crow(r, hi)) * 32 + r32; const float v = p[nb][r] * inv; *w = (g == 0) ? v : (*w + v); }
    }
    LDS_WAIT();
    float val[32];
#pragma unroll
    for (int j = 0; j < 32; ++j) val[j] = 0.f;
#pragma unroll
    for (int n = 0; n < 127; ++n) { const float v = wl[n * 32 + r32]; val[n >> 2] += v; if ((n & 3) == 3 && (n >> 2) + 1 < 32) val[(n >> 2) + 1] += v; }
    const int cur = t >> 6;
#pragma unroll
    for (int j = 0; j < 32; ++j) val[j] = (j > cur) ? -1.0f : ((j == 0 || j == cur || j == cur - 1) ? 1.0e4f : val[j]);
    unsigned mask = 0u;
#pragma unroll 1
    for (int itx = 0; itx < 8; ++itx) { float best = val[0]; int bj = 0;
#pragma unroll
        for (int j = 1; j < 32; ++j) if (val[j] > best) { best = val[j]; bj = j; }
        mask |= 1u << bj;
#pragma unroll
        for (int j = 0; j < 32; ++j) val[j] = (j == bj) ? -3.0e38f : val[j]; }
    if (hi == 0) ((GAS unsigned*)(F.wsb() + WS_SEL))[(size_t)(b * NHKV + hkv) * SEQ + t] = mask;
    LDS_WAIT();
}

template <int KIND  >
__device__ __forceinline__ float attn_softmax_tile(f32x16& p, int base, int t, int t0, int hi, float shift, float farb, const LAS float* bt, bool rowsel) {
    const bool nearb = (KIND == 0) ? true : ((t0 - base - 31) < 128);
    if (nearb) {
#pragma unroll
        for (int r = 0; r < 16; ++r) { const int c = crow(r, hi); const int d0 = (KIND == 0) ? (t - 16 * (base + c) - 31) : (t - (base + c)); const int i0 = d0 < 0 ? 0 : (d0 > 128 ? 128 : d0); p[r] = __builtin_fmaf(p[r], LOG2E, bt[i0] + shift); }
    } else {
#pragma unroll
        for (int r = 0; r < 16; ++r) p[r] = __builtin_fmaf(p[r], LOG2E, farb);
    }
    float ps = 0.f;
#pragma unroll
    for (int r = 0; r < 16; ++r) {
        const int c = crow(r, hi);
        const int d0 = (KIND == 0) ? (t - 16 * (base + c) - 31) : (t - (base + c));
        const bool v0 = (KIND == 0) ? (d0 >= 0) : ((KIND == 1) ? (rowsel && d0 >= 0) : ((unsigned)d0 < 512u));
        const float e = __builtin_amdgcn_exp2f(p[r]);
        const float e0 = v0 ? e : 0.f;
        p[r] = e0; ps += e0;
    }
    return ps;
}
__device__ __forceinline__ void attn_branch_end(f32x16 (&O)[4], float& lsum, float gate, LAS unsigned* yl, LAS float* fl, int lane, int r32, int hi, bool first) {
    float lt = sum32(lsum);
    const float f = lt > 0.f ? gate / lt : 0.f;
    if (hi == 0) fl[r32] = f;
    LDS_WAIT();
    float fr[16];
#pragma unroll
    for (int r = 0; r < 16; ++r) fr[r] = fl[crow(r, hi)];
#pragma unroll
    for (int db = 0; db < 4; ++db)
#pragma unroll
        for (int r2 = 0; r2 < 8; ++r2) { LAS unsigned* y = yl + (db * 8 + r2) * 64 + lane; float v0 = O[db][2 * r2] * fr[2 * r2], v1 = O[db][2 * r2 + 1] * fr[2 * r2 + 1];
            if (!first) { const unsigned w = *y; v0 += bflo(w); v1 += bfhi(w); }
            *y = pg8::cvt_pk_bf16(v0, v1); }
#pragma unroll
    for (int db = 0; db < 4; ++db) O[db] = (f32x16){};
    lsum = 0.f;
    LDS_WAIT();
}
__device__ __forceinline__ void nsa_attn_block(Frame& F, int l, int unit, int g, const LAS float* btab2, float kmax, float bmax) {
    const int lane = F.lane(), r32 = lane & 31, hi = lane >> 5, w = F.wave;
    const unsigned lo8 = (unsigned)lane * 8u;
    const int qb = 7 - unit / 32, grp = unit % 32, b = grp >> 1, hkv = grp & 1, T0 = qb * 256, t0 = T0 + 32 * w, t = t0 + r32; const size_t m = (size_t)b * SEQ + t;
    const GAS bf16* P = (const GAS bf16*)(F.wsb() + WS_PROJ);
    LAS bf16* kb = (LAS bf16*)(F.lds + RING_OFF); LAS bf16* vb = (LAS bf16*)(F.lds + RING_OFF + 16384);
    LAS unsigned* yl = (LAS unsigned*)(F.lds + RING_OFF + 32768 + w * 8192); LAS float* fl = (LAS float*)(F.lds + FL_OFF + w * 1024);
    const GAS bf16* KC = (const GAS bf16*)(F.wsb() + WS_KCB) + (size_t)(b * NHKV + hkv) * 128 * HD; const GAS bf16* VC = (const GAS bf16*)(F.wsb() + WS_VCT) + (size_t)(b * NHKV + hkv) * HD * 128;
    const GAS bf16* KSn = (const GAS bf16*)(F.wsb() + WS_KN) + (size_t)((0 * NBATCH + b) * NHKV + hkv) * 64 * 4096; const GAS bf16* KWn = (const GAS bf16*)(F.wsb() + WS_KN) + (size_t)((1 * NBATCH + b) * NHKV + hkv) * 64 * 4096;
    const GAS bf16* VSn = (const GAS bf16*)(F.wsb() + WS_VT) + (size_t)((0 * NBATCH + b) * NHKV + hkv) * 64 * 4096; const GAS bf16* VWn = (const GAS bf16*)(F.wsb() + WS_VT) + (size_t)((1 * NBATCH + b) * NHKV + hkv) * 64 * 4096;
    const unsigned mymask = ((const GAS unsigned*)(F.wsb() + WS_SEL))[(size_t)(b * NHKV + hkv) * SEQ + t];
    unsigned unw = wave_or(mymask); unw = (unsigned)__builtin_amdgcn_readfirstlane((int)unw);
    const int curmax = (T0 + 255) >> 6, ns = 2 * (curmax + 1), ilo = (T0 - 511 > 0 ? T0 - 511 : 0) >> 5, ihi = (T0 + 255) >> 5, total = ns + (ihi - ilo + 1);
    {
        const int h = hkv * 3 + g; const LAS float* bt = btab2 + h * 132;
        bf16x8 qf[8]; float qnorm;
        load_q(P + m * NPROJ + PC_NQ + h * HD, (const LAS float*)(F.lds + BTAB_OFF + 3200), hi, qf, qnorm);
        const float shift = -(qnorm * kmax + bmax) * LOG2E, farb = bt[128] + shift;
        f32x16 O[4];
#pragma unroll
        for (int db = 0; db < 4; ++db) O[db] = (f32x16){};
        float lsum = 0.f;
        { const int nvis = (t0 >> 4) + 1; int cnt = (nvis + 31) >> 5; if (cnt > 4) cnt = 4;
#pragma unroll 1
          for (int ti = 0; ti < cnt; ++ti) { const int base = 32 * ti;
              bf16x8 kf[8], vf[8];
#pragma unroll
              for (int ks = 0; ks < 8; ++ks) kf[ks] = ld16(KC + (size_t)(base + r32) * HD + 8 * hi + 16 * ks);
#pragma unroll
              for (int db = 0; db < 4; ++db)
#pragma unroll
                  for (int ks = 0; ks < 2; ++ks) vf[db * 2 + ks] = ld8x2(VC + (size_t)(32 * db + r32) * 128 + base + 16 * ks + 4 * hi);
              f32x16 p = (f32x16){};
#pragma unroll
              for (int ks = 0; ks < 8; ++ks) p = MFMA32(kf[ks], qf[ks], p);
              lsum += attn_softmax_tile<0>(p, base, t, t0, hi, shift, farb, bt, true);
              const bf16x8 pa0 = pack8f(p[0], p[1], p[2], p[3], p[4], p[5], p[6], p[7]), pa1 = pack8f(p[8], p[9], p[10], p[11], p[12], p[13], p[14], p[15]);
#pragma unroll
              for (int db = 0; db < 4; ++db) { O[db] = MFMA32(pa0, vf[db * 2], O[db]); O[db] = MFMA32(pa1, vf[db * 2 + 1], O[db]); } }
          const float g0 = sigmoid_f(bf2f(P[m * NPROJ + PC_NG + 0 * 6 + h]));
          attn_branch_end(O, lsum, g0, yl, fl, lane, r32, hi, true); }
        __syncthreads();
        { const GAS bf16* ks0 = KSn + (size_t)w * 512 + lo8; const GAS bf16* vs0 = VSn + (size_t)w * 512 + lo8;
          *(LAS v4u*)(kb + w * 512 + lo8) = *(const GAS v4u*)ks0; *(LAS v4u*)(vb + w * 512 + lo8) = *(const GAS v4u*)vs0; }
#pragma unroll 1
        for (int idx = 0; idx < total; ++idx) {
            __syncthreads();
            const bool issel = idx < ns; const int base = issel ? 32 * idx : 32 * (ilo + idx - ns);
            v4u kr, vr; const bool nxt = idx + 1 < total;
            if (nxt) { const int i1 = idx + 1; const bool s1 = i1 < ns; const int tile1 = s1 ? i1 : (ilo + i1 - ns);
                kr = *(const GAS v4u*)((s1 ? KSn : KWn) + (size_t)tile1 * 4096 + w * 512 + lo8); vr = *(const GAS v4u*)((s1 ? VSn : VWn) + (size_t)tile1 * 4096 + w * 512 + lo8); }
            const LAS bf16* kt = kb + (idx & 1) * 4096; const LAS bf16* vt = vb + (idx & 1) * 4096;
            const bool need = issel ? ((((unw >> (base >> 6)) & 1u) != 0u) && base <= t0 + 31) : (base + 31 >= t0 - 511 && base <= t0 + 31);
            if (need) {
                f32x16 p = (f32x16){};
                { bf16x8 k4[4];
#pragma unroll
                  for (int ks = 0; ks < 4; ++ks) k4[ks] = *(const LAS bf16x8*)(kt + ks * 512 + lo8);
#pragma unroll
                  for (int ks = 0; ks < 4; ++ks) p = MFMA32(k4[ks], qf[ks], p);
#pragma unroll
                  for (int ks = 0; ks < 4; ++ks) k4[ks] = *(const LAS bf16x8*)(kt + (4 + ks) * 512 + lo8);
#pragma unroll
                  for (int ks = 0; ks < 4; ++ks) p = MFMA32(k4[ks], qf[4 + ks], p); }
                lsum += issel ? attn_softmax_tile<1>(p, base, t, t0, hi, shift, farb, bt, ((mymask >> (base >> 6)) & 1u) != 0u) : attn_softmax_tile<2>(p, base, t, t0, hi, shift, farb, bt, true);
                const bf16x8 pa0 = pack8f(p[0], p[1], p[2], p[3], p[4], p[5], p[6], p[7]), pa1 = pack8f(p[8], p[9], p[10], p[11], p[12], p[13], p[14], p[15]);
#pragma unroll
                for (int db = 0; db < 4; ++db) { const bf16x8 v0 = *(const LAS bf16x8*)(vt + (db * 2) * 512 + lo8), v1 = *(const LAS bf16x8*)(vt + (db * 2 + 1) * 512 + lo8);
                    O[db] = MFMA32(pa0, v0, O[db]); O[db] = MFMA32(pa1, v1, O[db]); }
            }
            if (idx == ns - 1) { const float g1 = sigmoid_f(bf2f(P[m * NPROJ + PC_NG + 1 * 6 + h])); attn_branch_end(O, lsum, g1, yl, fl, lane, r32, hi, false); }
            if (nxt) { *(LAS v4u*)(kb + ((idx + 1) & 1) * 4096 + w * 512 + lo8) = kr; *(LAS v4u*)(vb + ((idx + 1) & 1) * 4096 + w * 512 + lo8) = vr; }
        }
        { const float g2 = sigmoid_f(bf2f(P[m * NPROJ + PC_NG + 2 * 6 + h])); float lt = sum32(lsum); const float f = lt > 0.f ? g2 / lt : 0.f;
          if (hi == 0) fl[r32] = f;
          LDS_WAIT();
          int lane2 = lane; asm volatile("" : "+v"(lane2));
          const int r32b = lane2 & 31, hib = lane2 >> 5;
          GAS bf16* Y = (GAS bf16*)(F.wsb() + WS_H) + ((size_t)b * SEQ + t0) * DM + 768 + h * HD + r32b + (size_t)(4 * hib) * DM;
#pragma unroll
          for (int r2 = 0; r2 < 8; ++r2) { const float fq0 = fl[crow(2 * r2, 0) + 4 * hib], fq1 = fl[crow(2 * r2 + 1, 0) + 4 * hib];
#pragma unroll
              for (int db = 0; db < 4; ++db) { const unsigned yw = yl[(db * 8 + r2) * 64 + lane2]; const float v0 = bflo(yw) + O[db][2 * r2] * fq0, v1 = bfhi(yw) + O[db][2 * r2 + 1] * fq1; const float n0 = xl1(v0), n1 = xl1(v1);
                  if ((r32b & 1) == 0) { *(GAS unsigned*)(Y + (size_t)crow(2 * r2, 0) * DM + 32 * db) = pk2(v0, n0); *(GAS unsigned*)(Y + (size_t)crow(2 * r2 + 1, 0) * DM + 32 * db) = pk2(v1, n1); } } }
          LDS_WAIT(); }
    }
    __syncthreads();
}

__device__ __forceinline__ float softplus_f(float x) { return fmaxf(x, 0.f) + __logf(1.0f + __expf(-fabsf(x))); }
__device__ __forceinline__ void ph_mix1(Frame& F, int l) {
    const int gw = F.vcu * NWAVES + F.wave, NGW = F.G * NWAVES, lane = F.lane();
    const GAS bf16* P = (const GAS bf16*)(F.wsb() + WS_PROJ);
    {
        GAS bf16* GQ = (GAS bf16*)(F.wsb() + WS_GQ); GAS bf16* GK = (GAS bf16*)(F.wsb() + WS_GK); GAS bf16* GV = (GAS bf16*)(F.wsb() + WS_GV);
        GAS float* GB = (GAS float*)(F.wsb() + WS_GBG); GAS float* GG = GB + NBATCH * GH * SEQ;
        const GAS float* cw = F.inp(I_GCONV) + (size_t)l * 2304 * 4;
        for (int it = gw; it < NBATCH * (SEQ / 8) * GH; it += NGW) {
            const int h = it % GH, r1 = it / GH, tb = r1 % (SEQ / 8), b = r1 / (SEQ / 8), t0 = tb * 8; const size_t m0 = (size_t)b * SEQ + t0;
            unsigned raw[3][11];
#pragma unroll
            for (int p = 0; p < 3; ++p)
#pragma unroll
                for (int j = 0; j < 11; ++j) { const int tt = t0 - 3 + j; raw[p][j] = (tt >= 0) ? *(const GAS unsigned*)(P + (m0 - 3 + j) * NPROJ + PC_GQKV + p * 768 + h * 128 + 2 * lane) : 0u; }
            float bb = 0.f, aa = 0.f;
            if (lane < 8) { bb = bf2f(P[(m0 + lane) * NPROJ + PC_GB + h]); aa = bf2f(P[(m0 + lane) * NPROJ + PC_GA + h]); }
            f32x4 w0[3], w1[3];
#pragma unroll
            for (int p = 0; p < 3; ++p) { const int ch = p * 768 + h * 128 + 2 * lane; w0[p] = *(const GAS f32x4*)(cw + (size_t)ch * 4); w1[p] = *(const GAS f32x4*)(cw + (size_t)(ch + 1) * 4); }
            const size_t o0 = ((size_t)(b * GH + h) * SEQ + t0) * HD + 2 * lane;
#pragma unroll
            for (int i = 0; i < 8; ++i) {
                float val[3][2];
#pragma unroll
                for (int p = 0; p < 3; ++p) { float a0 = 0.f, a1 = 0.f;
#pragma unroll
                    for (int j = 0; j < 4; ++j) { a0 += bflo(raw[p][i + j]) * w0[p][j]; a1 += bfhi(raw[p][i + j]) * w1[p][j]; }
                    val[p][0] = pg8::silu_f(a0); val[p][1] = pg8::silu_f(a1); }
                const float sq = wave_sum(val[0][0] * val[0][0] + val[0][1] * val[0][1]), sk = wave_sum(val[1][0] * val[1][0] + val[1][1] * val[1][1]);
                const float rq = (1.0f / sqrtf(sq + RMS_EPS)) * 0.08838834764831845f, rk = 1.0f / sqrtf(sk + RMS_EPS);
                *(GAS unsigned*)(GQ + o0 + (size_t)i * HD) = pk2(val[0][0] * rq, val[0][1] * rq);
                *(GAS unsigned*)(GK + o0 + (size_t)i * HD) = pk2(val[1][0] * rk, val[1][1] * rk);
                *(GAS unsigned*)(GV + o0 + (size_t)i * HD) = pk2(val[2][0], val[2][1]);
            }
            if (lane < 8) {
                GB[(size_t)(b * GH + h) * SEQ + t0 + lane] = sigmoid_f(bb);
                GG[(size_t)(b * GH + h) * SEQ + t0 + lane] = -__expf(F.inp(I_GALOG)[l * GH + h]) * softplus_f(aa + F.inp(I_GDT)[l * GH + h]);
            }
        }
    }
    __syncthreads();
    for (int it = F.vcu; it < 2 * NBATCH * NHKV * 4; it += F.G) cmp_unit(F, l, it);
}

__device__ __forceinline__ void gdn_chunk_unit(Frame& F, int item, LAS float* wl, LAS float* sl) {
    const int lane = F.lane(), r32 = lane & 31, hi = lane >> 5;
    const size_t tok0 = (size_t)item * 64;
    GAS bf16* GQ = (GAS bf16*)(F.wsb() + WS_GQ) + tok0 * HD; GAS bf16* GK = (GAS bf16*)(F.wsb() + WS_GK) + tok0 * HD; GAS bf16* GV = (GAS bf16*)(F.wsb() + WS_GV) + tok0 * HD;
    const GAS float* GB = (const GAS float*)(F.wsb() + WS_GBG) + tok0; const GAS float* GG = GB + NBATCH * GH * SEQ;
    float gc = GG[lane]; const float beta = GB[lane];
#pragma unroll
    for (int o = 1; o < 64; o <<= 1) { const float v = __int_as_float(__builtin_amdgcn_ds_bpermute((lane - o) << 2, __float_as_int(gc))); if (lane >= o) gc += v; }
    const float glast = rl(gc, 63);
    sl[lane] = gc; sl[64 + lane] = beta; sl[128 + lane] = __expf(gc); sl[192 + lane] = __expf(glast - gc);
    if (lane == 0) ((GAS float*)(F.wsb() + WS_EGL))[item] = __expf(glast);
    LDS_WAIT();
    {
        bf16x8 kfr[2][8];
#pragma unroll
        for (int rb = 0; rb < 2; ++rb)
#pragma unroll
            for (int ks = 0; ks < 8; ++ks) kfr[rb][ks] = ld16(GK + (size_t)(32 * rb + r32) * HD + 16 * ks + 8 * hi);
#pragma unroll
        for (int tI = 0; tI < 3; ++tI) { const int rb = (tI == 2) ? 1 : 0, cb = (tI == 0) ? 0 : 1;
            f32x16 acc = (f32x16){};
#pragma unroll
            for (int ks = 0; ks < 8; ++ks) acc = MFMA32(kfr[rb][ks], kfr[cb][ks], acc);
            const int s_ = 32 * cb + r32; const float gcs = sl[s_], bs = sl[64 + s_];
#pragma unroll
            for (int r = 0; r < 16; ++r) { const int c = 32 * rb + crow(r, hi); wl[c * 64 + s_] = (s_ > c) ? bs * acc[r] * __expf(gcs - sl[c]) : 0.f; }
        }
        GAS bf16* ATT = (GAS bf16*)(F.wsb() + WS_ATT) + (size_t)item * 4096;
#pragma unroll
        for (int ib = 0; ib < 2; ++ib) {
            bf16x8 qfr[8];
#pragma unroll
            for (int ks = 0; ks < 8; ++ks) qfr[ks] = ld16(GQ + (size_t)(32 * ib + r32) * HD + 16 * ks + 8 * hi);
            const int i_ = 32 * ib + r32; const float gci = sl[i_];
#pragma unroll
            for (int jb = 0; jb < 2; ++jb) { f32x16 acc = (f32x16){};
                if (!(ib == 0 && jb == 1)) {
#pragma unroll
                    for (int ks = 0; ks < 8; ++ks) acc = MFMA32(kfr[jb][ks], qfr[ks], acc);
                }
                float av[16];
#pragma unroll
                for (int r = 0; r < 16; ++r) { const int j_ = 32 * jb + crow(r, hi); av[r] = (j_ <= i_) ? acc[r] * __expf(gci - sl[j_]) : 0.f; }
                *(GAS bf16x8*)(ATT + ((ib * 4 + jb * 2 + 0) * 64 + lane) * 8) = pack8f(av[0], av[1], av[2], av[3], av[4], av[5], av[6], av[7]);
                *(GAS bf16x8*)(ATT + ((ib * 4 + jb * 2 + 1) * 64 + lane) * 8) = pack8f(av[8], av[9], av[10], av[11], av[12], av[13], av[14], av[15]); }
        }
    }
    LDS_WAIT();
    float yv[64];
#pragma unroll
    for (int c = 63; c >= 0; --c) {
        float acc = (c == lane) ? 1.0f : 0.0f;
#pragma unroll
        for (int s4 = ((c + 1) & ~3); s4 < 64; s4 += 4) { const f32x4 mv = *(const LAS f32x4*)(wl + c * 64 + s4);
            if (s4 + 0 > c) acc = __builtin_fmaf(-mv.x, yv[s4 + 0], acc); if (s4 + 1 > c) acc = __builtin_fmaf(-mv.y, yv[s4 + 1], acc); if (s4 + 2 > c) acc = __builtin_fmaf(-mv.z, yv[s4 + 2], acc); if (s4 + 3 > c) acc = __builtin_fmaf(-mv.w, yv[s4 + 3], acc); }
        yv[c] = acc;
        asm volatile("" ::: "memory");
    }
    unsigned au[4][2][4], aw[4][2][4];
#pragma unroll
    for (int ks = 0; ks < 4; ++ks) { unsigned pu[8], pw[8];
#pragma unroll
        for (int d = 0; d < 8; ++d) { const int c0 = 16 * ks + 2 * d; const float b0 = sl[64 + c0], b1 = sl[64 + c0 + 1], e0 = sl[128 + c0], e1 = sl[128 + c0 + 1];
            pu[d] = pg8::cvt_pk_bf16(yv[c0] * b0, yv[c0 + 1] * b1); pw[d] = pg8::cvt_pk_bf16(yv[c0] * b0 * e0, yv[c0 + 1] * b1 * e1); }
#pragma unroll
        for (int i = 0; i < 4; ++i) { auto ru = __builtin_amdgcn_permlane32_swap(pu[i], pu[4 + i], false, false); au[ks][0][i] = ru[0]; au[ks][1][i] = ru[1];
            auto rw = __builtin_amdgcn_permlane32_swap(pw[i], pw[4 + i], false, false); aw[ks][0][i] = rw[0]; aw[ks][1][i] = rw[1]; } }
    LDS_WAIT();
    LAS bf16* tl = (LAS bf16*)wl;
    {
#pragma unroll
        for (int i = 0; i < 16; ++i) { const int row = 4 * i + (lane >> 4), chn = lane & 15; *(LAS v4u*)(tl + row * HD + 8 * chn) = *(const GAS v4u*)(GV + (size_t)row * HD + 8 * chn); }
        LDS_WAIT();
        GAS bf16* GU = (GAS bf16*)(F.wsb() + WS_GU) + (size_t)item * 8192;
#pragma unroll 1
        for (int eb = 0; eb < 4; ++eb) { f32x16 a0 = (f32x16){}, a1 = (f32x16){};
#pragma unroll
            for (int ks = 0; ks < 4; ++ks) { unsigned w[4];
#pragma unroll
                for (int j = 0; j < 4; ++j) w[j] = (unsigned)tl[(16 * ks + 8 * hi + 2 * j) * HD + 32 * eb + r32] | ((unsigned)tl[(16 * ks + 8 * hi + 2 * j + 1) * HD + 32 * eb + r32] << 16);
                v4u bw; bw.x = w[0]; bw.y = w[1]; bw.z = w[2]; bw.w = w[3]; const bf16x8 bfr = __builtin_bit_cast(bf16x8, bw);
                v4u x0; x0.x = au[ks][0][0]; x0.y = au[ks][0][1]; x0.z = au[ks][0][2]; x0.w = au[ks][0][3]; v4u x1; x1.x = au[ks][1][0]; x1.y = au[ks][1][1]; x1.z = au[ks][1][2]; x1.w = au[ks][1][3];
                a0 = MFMA32(__builtin_bit_cast(bf16x8, x0), bfr, a0); a1 = MFMA32(__builtin_bit_cast(bf16x8, x1), bfr, a1); }
            for (int hf = 0; hf < 2; ++hf) { v4u w0, w1;
                w0.x = pg8::cvt_pk_bf16(a0[8 * hf + 0], a0[8 * hf + 1]); w0.y = pg8::cvt_pk_bf16(a0[8 * hf + 2], a0[8 * hf + 3]); w0.z = pg8::cvt_pk_bf16(a0[8 * hf + 4], a0[8 * hf + 5]); w0.w = pg8::cvt_pk_bf16(a0[8 * hf + 6], a0[8 * hf + 7]);
                w1.x = pg8::cvt_pk_bf16(a1[8 * hf + 0], a1[8 * hf + 1]); w1.y = pg8::cvt_pk_bf16(a1[8 * hf + 2], a1[8 * hf + 3]); w1.z = pg8::cvt_pk_bf16(a1[8 * hf + 4], a1[8 * hf + 5]); w1.w = pg8::cvt_pk_bf16(a1[8 * hf + 6], a1[8 * hf + 7]);
                *(GAS v4u*)(GU + ((eb * 2 + 0) * 64 + lane) * 16 + 8 * hf) = w0; *(GAS v4u*)(GU + ((eb * 2 + 1) * 64 + lane) * 16 + 8 * hf) = w1; } }
        LDS_WAIT();
    }
    {
#pragma unroll
        for (int i = 0; i < 16; ++i) { const int row = 4 * i + (lane >> 4), chn = lane & 15; *(LAS v4u*)(tl + row * HD + 8 * chn) = *(const GAS v4u*)(GK + (size_t)row * HD + 8 * chn); }
        LDS_WAIT();
#pragma unroll 1
        for (int db = 0; db < 4; ++db) { f32x16 a0 = (f32x16){}, a1 = (f32x16){};
#pragma unroll
            for (int ks = 0; ks < 4; ++ks) { unsigned w[4];
#pragma unroll
                for (int j = 0; j < 4; ++j) w[j] = (unsigned)tl[(16 * ks + 8 * hi + 2 * j) * HD + 32 * db + r32] | ((unsigned)tl[(16 * ks + 8 * hi + 2 * j + 1) * HD + 32 * db + r32] << 16);
                v4u bw; bw.x = w[0]; bw.y = w[1]; bw.z = w[2]; bw.w = w[3]; const bf16x8 kT = __builtin_bit_cast(bf16x8, bw);
                v4u x0; x0.x = aw[ks][0][0]; x0.y = aw[ks][0][1]; x0.z = aw[ks][0][2]; x0.w = aw[ks][0][3]; v4u x1; x1.x = aw[ks][1][0]; x1.y = aw[ks][1][1]; x1.z = aw[ks][1][2]; x1.w = aw[ks][1][3];
                a0 = MFMA32(kT, __builtin_bit_cast(bf16x8, x0), a0); a1 = MFMA32(kT, __builtin_bit_cast(bf16x8, x1), a1); }
#pragma unroll
            for (int s2 = 0; s2 < 2; ++s2) {
                *(GAS bf16x8*)(GV + ((0 * 8 + db * 2 + s2) * 64 + lane) * 8) = pack8f(-a0[8 * s2 + 0], -a0[8 * s2 + 1], -a0[8 * s2 + 2], -a0[8 * s2 + 3], -a0[8 * s2 + 4], -a0[8 * s2 + 5], -a0[8 * s2 + 6], -a0[8 * s2 + 7]);
                *(GAS bf16x8*)(GV + ((1 * 8 + db * 2 + s2) * 64 + lane) * 8) = pack8f(-a1[8 * s2 + 0], -a1[8 * s2 + 1], -a1[8 * s2 + 2], -a1[8 * s2 + 3], -a1[8 * s2 + 4], -a1[8 * s2 + 5], -a1[8 * s2 + 6], -a1[8 * s2 + 7]); } }
#pragma unroll 1
        for (int db = 0; db < 4; ++db)
#pragma unroll
            for (int f = 0; f < 4; ++f) { float v[8];
#pragma unroll
                for (int j = 0; j < 8; ++j) { const int c = 32 * (f >> 1) + 16 * (f & 1) + 8 * (j >> 2) + 4 * hi + (j & 3); v[j] = bf2f(tl[c * HD + 32 * db + r32]) * sl[192 + c]; }
                *(GAS bf16x8*)(GK + ((db * 4 + f) * 64 + lane) * 8) = pack8f(v[0], v[1], v[2], v[3], v[4], v[5], v[6], v[7]); }
        LDS_WAIT();
    }
    {
        bf16x8 qa[16];
#pragma unroll
        for (int i = 0; i < 16; ++i) qa[i] = ld8x2(GQ + (size_t)(32 * (i >> 3) + r32) * HD + 32 * ((i >> 1) & 3) + 16 * (i & 1) + 4 * hi);
        const float e0 = sl[128 + r32], e1 = sl[128 + 32 + r32];
        asm volatile("s_waitcnt vmcnt(0)" ::: "memory");
#pragma unroll
        for (int i = 0; i < 16; ++i) { const float e = (i < 8) ? e0 : e1; const v4u w = __builtin_bit_cast(v4u, qa[i]);
            *(GAS bf16x8*)(GQ + (i * 64 + lane) * 8) = pack8f(bflo(w.x) * e, bfhi(w.x) * e, bflo(w.y) * e, bfhi(w.y) * e, bflo(w.z) * e, bfhi(w.z) * e, bflo(w.w) * e, bfhi(w.w) * e); }
    }
    LDS_WAIT();
}
__device__ __forceinline__ void gdn_scan_block(Frame& F, int bh) {
    const int lane = F.lane(), r32 = lane & 31, hi = lane >> 5, w = F.wave;
    const unsigned lo8 = (unsigned)lane * 8u, lo16 = (unsigned)lane * 16u;
    constexpr int IMG = 57344, O_W = 0, O_QG = 16384, O_KD = 32768, O_AT = 49152;
    LAS unsigned char* ring = F.lds + RING_OFF;
    const GAS bf16* Wg = (const GAS bf16*)(F.wsb() + WS_GV) + (size_t)bh * SEQ * HD; const GAS bf16* QGg = (const GAS bf16*)(F.wsb() + WS_GQ) + (size_t)bh * SEQ * HD;
    const GAS bf16* KDg = (const GAS bf16*)(F.wsb() + WS_GK) + (size_t)bh * SEQ * HD; const GAS bf16* ATg = (const GAS bf16*)(F.wsb() + WS_ATT) + (size_t)bh * 32 * 4096;
    __syncthreads();
    if (w >= 4) {
        const int ld = w - 4;
#pragma unroll 1
        for (int c = -1; c < 32; ++c) {
            if (c + 1 < 32) { const int cn = c + 1; LAS unsigned char* img = ring + (cn & 1) * IMG;
                v4u rw[4], rq[4], rk[4], ra[2];
#pragma unroll
                for (int i = 0; i < 4; ++i) { rw[i] = *(const GAS v4u*)(Wg + (size_t)cn * 64 * HD + (4 * ld + i) * 512 + lo8); rq[i] = *(const GAS v4u*)(QGg + (size_t)cn * 64 * HD + (4 * ld + i) * 512 + lo8);
                    rk[i] = *(const GAS v4u*)(KDg + (size_t)cn * 64 * HD + (4 * ld + i) * 512 + lo8); }
#pragma unroll
                for (int i = 0; i < 2; ++i) ra[i] = *(const GAS v4u*)(ATg + (size_t)cn * 4096 + (2 * ld + i) * 512 + lo8);
#pragma unroll
                for (int i = 0; i < 4; ++i) { *(LAS v4u*)(img + O_W + (4 * ld + i) * 1024 + lo16) = rw[i]; *(LAS v4u*)(img + O_QG + (4 * ld + i) * 1024 + lo16) = rq[i]; *(LAS v4u*)(img + O_KD + (4 * ld + i) * 1024 + lo16) = rk[i]; }
#pragma unroll
                for (int i = 0; i < 2; ++i) *(LAS v4u*)(img + O_AT + (2 * ld + i) * 1024 + lo16) = ra[i];
            }
            __syncthreads();
        }
    } else {
        const int es = w, b = bh / GH, h = bh % GH;
        f32x16 S[4];
#pragma unroll
        for (int db = 0; db < 4; ++db) S[db] = (f32x16){};
        GAS bf16* GOb = (GAS bf16*)(F.wsb() + WS_GO) + (size_t)b * SEQ * 768 + h * HD + 32 * es + r32;
        const GAS bf16* GUg = (const GAS bf16*)(F.wsb() + WS_GU) + (size_t)bh * 32 * 8192 + es * 2048; const GAS float* EG = (const GAS float*)(F.wsb() + WS_EGL) + bh * 32;
        v4u g0a = *(const GAS v4u*)(GUg + lo16), g0b = *(const GAS v4u*)(GUg + lo16 + 8), g1a = *(const GAS v4u*)(GUg + 1024 + lo16), g1b = *(const GAS v4u*)(GUg + 1024 + lo16 + 8);
        float eg = EG[0];
        __syncthreads();
#pragma unroll 1
        for (int ch = 0; ch < 32; ++ch) {
            const LAS bf16* img = (const LAS bf16*)(ring + (ch & 1) * IMG);
            const LAS bf16* Wl = img + O_W / 2 + lo8; const LAS bf16* QGl = img + O_QG / 2 + lo8; const LAS bf16* KDl = img + O_KD / 2 + lo8; const LAS bf16* ATl = img + O_AT / 2 + lo8;
            bf16x8 Sb[4][2];
#pragma unroll
            for (int db = 0; db < 4; ++db) { Sb[db][0] = pack8f(S[db][0], S[db][1], S[db][2], S[db][3], S[db][4], S[db][5], S[db][6], S[db][7]); Sb[db][1] = pack8f(S[db][8], S[db][9], S[db][10], S[db][11], S[db][12], S[db][13], S[db][14], S[db][15]); }
            f32x16 VN[2], OT[2];
#pragma unroll
            for (int i = 0; i < 4; ++i) { VN[0][2 * i] = bflo(g0a[i]); VN[0][2 * i + 1] = bfhi(g0a[i]); VN[0][8 + 2 * i] = bflo(g0b[i]); VN[0][8 + 2 * i + 1] = bfhi(g0b[i]);
                VN[1][2 * i] = bflo(g1a[i]); VN[1][2 * i + 1] = bfhi(g1a[i]); VN[1][8 + 2 * i] = bflo(g1b[i]); VN[1][8 + 2 * i + 1] = bfhi(g1b[i]); }
            const float egc = eg;
            if (ch + 1 < 32) { const GAS bf16* GUn = GUg + (size_t)(ch + 1) * 8192;
                g0a = *(const GAS v4u*)(GUn + lo16); g0b = *(const GAS v4u*)(GUn + lo16 + 8); g1a = *(const GAS v4u*)(GUn + 1024 + lo16); g1b = *(const GAS v4u*)(GUn + 1024 + lo16 + 8); eg = EG[ch + 1]; }
#pragma unroll
            for (int rb = 0; rb < 2; ++rb)
#pragma unroll
                for (int i = 0; i < 8; ++i) VN[rb] = MFMA32(*(const LAS bf16x8*)(Wl + (rb * 8 + i) * 512), Sb[i >> 1][i & 1], VN[rb]);
            bf16x8 VNb[2][2];
#pragma unroll
            for (int cb = 0; cb < 2; ++cb) { VNb[cb][0] = pack8f(VN[cb][0], VN[cb][1], VN[cb][2], VN[cb][3], VN[cb][4], VN[cb][5], VN[cb][6], VN[cb][7]); VNb[cb][1] = pack8f(VN[cb][8], VN[cb][9], VN[cb][10], VN[cb][11], VN[cb][12], VN[cb][13], VN[cb][14], VN[cb][15]); }
#pragma unroll
            for (int db = 0; db < 4; ++db) { S[db] = S[db] * egc;
#pragma unroll
                for (int j = 0; j < 4; ++j) S[db] = MFMA32(*(const LAS bf16x8*)(KDl + (db * 4 + j) * 512), VNb[j >> 1][j & 1], S[db]); }
#pragma unroll
            for (int rb = 0; rb < 2; ++rb) { OT[rb] = (f32x16){};
#pragma unroll
                for (int i = 0; i < 8; ++i) OT[rb] = MFMA32(*(const LAS bf16x8*)(QGl + (rb * 8 + i) * 512), Sb[i >> 1][i & 1], OT[rb]);
#pragma unroll
                for (int j = 0; j < 4; ++j) OT[rb] = MFMA32(*(const LAS bf16x8*)(ATl + (rb * 4 + j) * 512), VNb[j >> 1][j & 1], OT[rb]);
#pragma unroll
                for (int r = 0; r < 16; ++r) { const float v = OT[rb][r]; const float vn = xl1(v);
                    if ((r32 & 1) == 0) *(GAS unsigned*)(GOb + (size_t)(ch * 64 + 32 * rb + crow(r, hi)) * 768) = pk2(v, vn); } }
            __syncthreads();
        }
    }
}
__device__ __forceinline__ void ph_fill(Frame& F, int l, int first, int stride) {
    const int lane = F.lane();
    const GAS bf16* P = (const GAS bf16*)(F.wsb() + WS_PROJ);
    {
        GAS bf16* KN = (GAS bf16*)(F.wsb() + WS_KN);
        for (int it = first; it < NBATCH * (SEQ / 8); it += stride) {
            const int tb = it % (SEQ / 8), b = it / (SEQ / 8), t0 = tb * 8; const size_t m0 = (size_t)b * SEQ + t0;
            unsigned raw[8][4];
#pragma unroll
            for (int i = 0; i < 8; ++i)
#pragma unroll
                for (int q = 0; q < 4; ++q) raw[i][q] = *(const GAS unsigned*)(P + (m0 + i) * NPROJ + PC_NKV + (2 + 2 * (q >> 1)) * 256 + (q & 1) * 128 + 2 * lane);
            float kn[2][2];
#pragma unroll
            for (int w = 0; w < 2; ++w) { const GAS float* kp_ = F.inp(I_NKN) + (size_t)(l * 3 + 1 + w) * HD + 2 * lane; kn[w][0] = kp_[0]; kn[w][1] = kp_[1]; }
#pragma unroll
            for (int i = 0; i < 8; ++i)
#pragma unroll
                for (int q = 0; q < 4; ++q) { const int which = q >> 1, hkv = q & 1; const float a0 = bflo(raw[i][q]), a1 = bfhi(raw[i][q]);
                    const float rs = 1.0f / sqrtf(wave_sum(a0 * a0 + a1 * a1) * (1.f / HD) + RMS_EPS);
                    { const int key = t0 + i, d = 2 * lane;
                      *(GAS unsigned*)(KN + ((size_t)((which * NBATCH + b) * NHKV + hkv) * 64 + (key >> 5)) * 4096 + (((d >> 4) * 64 + (key & 31) + 32 * ((d >> 3) & 1)) * 8 + (d & 7))) = pk2(a0 * rs * kn[which][0], a1 * rs * kn[which][1]); } }
        }
    }
    {
        GAS bf16* Y = (GAS bf16*)(F.wsb() + WS_H);
        const GAS float* sw = F.inp(I_SCW) + (size_t)l * 512 * 3;
        for (int it = first; it < NBATCH * (SEQ / 8); it += stride) {
            const int tb = it % (SEQ / 8), b = it / (SEQ / 8), t0 = tb * 8; const size_t m0 = (size_t)b * SEQ + t0; const int c0 = 8 * lane;
            v4u ru[10], rc[10], rb[8];
#pragma unroll
            for (int j = 0; j < 10; ++j) { const int tt = t0 - 2 + j; if (tt >= 0) { ru[j] = *(const GAS v4u*)(P + (m0 - 2 + j) * NPROJ + PC_CU + c0); rc[j] = *(const GAS v4u*)(P + (m0 - 2 + j) * NPROJ + PC_CC + c0); } else { ru[j] = (v4u){0u, 0u, 0u, 0u}; rc[j] = (v4u){0u, 0u, 0u, 0u}; } }
#pragma unroll
            for (int i = 0; i < 8; ++i) rb[i] = *(const GAS v4u*)(P + (m0 + i) * NPROJ + PC_CB + c0);
            float wv[8][3];
#pragma unroll
            for (int c = 0; c < 8; ++c)
#pragma unroll
                for (int j = 0; j < 3; ++j) wv[c][j] = sw[(c0 + c) * 3 + j];
#pragma unroll
            for (int i = 0; i < 8; ++i) { float acc[8];
#pragma unroll
                for (int c = 0; c < 8; ++c) acc[c] = 0.f;
#pragma unroll
                for (int j = 0; j < 3; ++j)
#pragma unroll
                    for (int q = 0; q < 4; ++q) { acc[2 * q] += bflo(ru[i + j][q]) * bflo(rc[i + j][q]) * wv[2 * q][j]; acc[2 * q + 1] += bfhi(ru[i + j][q]) * bfhi(rc[i + j][q]) * wv[2 * q + 1][j]; }
                v4u o;
#pragma unroll
                for (int q = 0; q < 4; ++q) o[q] = pk2(acc[2 * q] * bflo(rb[i][q]), acc[2 * q + 1] * bfhi(rb[i][q]));
                *(GAS v4u*)(Y + (m0 + i) * DM + 1536 + c0) = o; }
        }
    }
    {
        LAS bf16* tl = (LAS bf16*)(F.lds + RING_OFF + F.wave * 16384);
        GAS bf16* VT = (GAS bf16*)(F.wsb() + WS_VT);
        const int r32 = lane & 31, hi = lane >> 5;
        for (int it = first; it < 2 * NBATCH * NHKV * 64; it += stride) {
            const int tb = it & 63, r1 = it >> 6, hkv = r1 & 1, r2 = r1 >> 1, b = r2 % NBATCH, which = r2 / NBATCH;
            const GAS bf16* src = P + ((size_t)b * SEQ + 32 * tb) * NPROJ + PC_NKV + (3 + 2 * which) * 256 + hkv * 128;
            GAS bf16* dst = VT + ((size_t)((which * NBATCH + b) * NHKV + hkv) * 64 + tb) * 4096;
            { v4u tv[8];
#pragma unroll
              for (int i = 0; i < 8; ++i) { const int tok = i * 4 + (lane >> 4), ch = lane & 15; tv[i] = *(const GAS v4u*)(src + (size_t)tok * NPROJ + 8 * ch); }
#pragma unroll
              for (int i = 0; i < 8; ++i) { const int tok = i * 4 + (lane >> 4), ch = lane & 15; *(LAS v4u*)(tl + tok * 136 + 8 * ch) = tv[i]; } }
            LDS_WAIT();
#pragma unroll
            for (int f = 0; f < 8; ++f) { const int db = f >> 1, ks = f & 1; unsigned w[4];
#pragma unroll
                for (int jj = 0; jj < 4; ++jj) { const int j0 = 2 * jj, k0 = 16 * ks + 8 * (j0 >> 2) + 4 * hi + (j0 & 3);
                    w[jj] = (unsigned)tl[k0 * 136 + 32 * db + r32] | ((unsigned)tl[(k0 + 1) * 136 + 32 * db + r32] << 16); }
                v4u o; o.x = w[0]; o.y = w[1]; o.z = w[2]; o.w = w[3];
                *(GAS v4u*)(dst + (f * 64 + lane) * 8) = o; }
            LDS_WAIT();
        }
    }
}

__device__ __forceinline__ void nsa_tables(Frame& F, int l, float& kmax, float& bmax) {
    LAS float* btab2 = (LAS float*)(F.lds + BTAB_OFF);
    for (int i = F.tid(); i < 6 * 132; i += NWAVES * 64) { const int h = i / 132, d = i % 132; btab2[i] = F.inp(I_RELB)[(d < 128 ? (int)T5B[d] : 31) * 6 + h] * LOG2E; }
    for (int i = F.tid(); i < HD; i += NWAVES * 64) ((LAS float*)(F.lds + BTAB_OFF + 3200))[i] = F.inp(I_NQN)[(size_t)l * HD + i];
    const GAS float* kn = F.inp(I_NKN) + (size_t)l * 3 * HD; float km = 0.f, bm = 0.f;
    for (int i = F.lane(); i < 3 * HD; i += 64) km = fmaxf(km, fabsf(kn[i]));
    for (int i = F.lane(); i < 192; i += 64) bm = fmaxf(bm, fabsf(F.inp(I_RELB)[i]));
    kmax = wave_max(km) * 11.313708498984761f; bmax = wave_max(bm);
    __syncthreads();
}
__device__ __forceinline__ void ph_select(Frame& F, int l) {
    float kmax, bmax; nsa_tables(F, l, kmax, bmax);
    const int gw = F.vcu * NWAVES + F.wave, NGW = F.G * NWAVES;
    LAS float* wl = (LAS float*)(F.lds + RING_OFF + F.wave * 16384);
    for (int it = gw; it < NBATCH * GH * 32; it += NGW) gdn_chunk_unit(F, it, wl, (LAS float*)(F.lds + FL_OFF + F.wave * 1024));
    { const int two = NBATCH * GH * 32 - NGW; if (two > 0 && two < NGW) { if (gw >= two) ph_fill(F, l, gw - two, NGW - two); } else ph_fill(F, l, gw, NGW); }
    for (int it = gw; it < NBATCH * NHKV * 64; it += NGW) nsa_select_unit(F, l, it, wl, (const LAS float*)(F.lds + BTAB_OFF), kmax, bmax);
}
__device__ __forceinline__ void ph_mix2(Frame& F, int l) {
    float kmax, bmax; nsa_tables(F, l, kmax, bmax);
    const int bx = (int)blockIdx.x;
    if (bx < 96) gdn_scan_block(F, bx);
    volatile LAS int* tk = (volatile LAS int*)(F.lds + MISC_OFF + 64);
    gu32* qctr = F.ctl + CW_Q + 64 * (8 + l);
    const int home = (bx < 96) ? (255 - bx) : (bx - 96);
#pragma unroll 1
    for (int k = 0;; ++k) {
        int u, g;
        if (k < 2 && bx < 256 && (int)gridDim.x >= 256) { u = home; g = k; }
        else {
            if (F.tid() == 0) tk[0] = (int)__hip_atomic_fetch_add(qctr, 1u, RLX_AGENT);
            __syncthreads();
            const int j = tk[0];
            __syncthreads();
            if ((int)gridDim.x >= 256) { if (j >= 256) break; u = j; g = 2; } else { if (j >= 768) break; u = j / 3; g = j % 3; }
        }
        nsa_attn_block(F, l, u, g, (const LAS float*)(F.lds + BTAB_OFF), kmax, bmax);
    }
}
__device__ __forceinline__ void ph_mix3(Frame& F, int l) {
    const int gw = F.vcu * NWAVES + F.wave, NGW = F.G * NWAVES, lane = F.lane();
    const GAS bf16* P = (const GAS bf16*)(F.wsb() + WS_PROJ); const GAS bf16* GO = (const GAS bf16*)(F.wsb() + WS_GO); GAS bf16* Y = (GAS bf16*)(F.wsb() + WS_H);
    const GAS float* gn = F.inp(I_GNORM) + (size_t)l * HD + 2 * lane;
    for (int it = gw; it < (MTOK / 16) * GH; it += NGW) { const int h = it % GH; const size_t m0 = (size_t)(it / GH) * 16;
        unsigned ow[16], zw[16];
#pragma unroll
        for (int i = 0; i < 16; ++i) { ow[i] = *(const GAS unsigned*)(GO + (m0 + i) * 768 + h * HD + 2 * lane); zw[i] = *(const GAS unsigned*)(P + (m0 + i) * NPROJ + PC_GZ + h * HD + 2 * lane); }
        const float g0 = gn[0], g1 = gn[1];
#pragma unroll
        for (int i = 0; i < 16; ++i) { const float ox = bflo(ow[i]), oy = bfhi(ow[i]);
            const float rs = 1.0f / sqrtf(wave_sum(ox * ox + oy * oy) * (1.f / HD) + RMS_EPS);
            *(GAS unsigned*)(Y + (m0 + i) * DM + h * HD + 2 * lane) = pk2(ox * rs * g0 * pg8::silu_f(bflo(zw[i])), oy * rs * g1 * pg8::silu_f(bfhi(zw[i]))); }
    }
}

struct Args { const GAS float* in[19]; GAS float* out; GAS unsigned char* ws; int l_lo, l_hi, ph_lo, ph_hi; };
__global__ void __launch_bounds__(NWAVES * 64, 2) trunk_fwd(Args args) {
    extern __shared__ __attribute__((aligned(16))) unsigned char lds[];
    Frame F;
    F.lds = (LAS unsigned char*)lds;
    { int w_ = __builtin_amdgcn_readfirstlane((int)threadIdx.x >> 6); asm volatile("" : "+s"(w_)); F.wave = w_; }
    F.G = gridDim.x; { const int bx = blockIdx.x; F.vcu = (F.G % 8 == 0) ? (bx % 8) * (F.G / 8) + bx / 8 : bx; }
    F.kp = (const __attribute__((address_space(4))) unsigned char*)__builtin_amdgcn_kernarg_segment_ptr(); F.ws_ = args.ws; F.ctl = (gu32*)(args.ws + WS_CTL); F.out = args.out;
    for (int u = F.tid(); u < (LDS_BYTES - LDSCTL_OFF) / 4; u += NWAVES * 64) ((LAS unsigned*)(F.lds + LDSCTL_OFF))[u] = 0u;
    __syncthreads();
#if MK_ONE_LAUNCH
    XcdBarrier bar = xcd_barrier_post((GAS unsigned*)(F.ctl + CW_BAR), (volatile LAS unsigned*)(F.lds + MISC_OFF) + 8);
#define GRID_BAR() xcd_barrier(bar, F.tid())
#else
#define GRID_BAR() do {} while (0)
#endif
    GAS bf16* WIN = (GAS bf16*)(F.wsb() + WS_WIN); GAS bf16* WOUT = (GAS bf16*)(F.wsb() + WS_WOUT); GAS bf16* WGU = (GAS bf16*)(F.wsb() + WS_WGU); GAS bf16* WDN = (GAS bf16*)(F.wsb() + WS_WDN);
    GAS bf16* H = (GAS bf16*)(F.wsb() + WS_H); GAS bf16* PROJ = (GAS bf16*)(F.wsb() + WS_PROJ);
    for (int l = args.l_lo; l < args.l_hi; ++l) {
        const GAS float* xin = (l == 0) ? F.inp(I_X) : F.out;
#define IN(k) (args.ph_lo <= (k) && (k) < args.ph_hi)
        if (IN(0)) { ph_convert(F, l); ph_norm(F, xin, F.inp(I_NMIX) + (size_t)l * DM); GRID_BAR(); }
        if (IN(1)) { pg8::Gemm g{H, WIN, MTOK, NPROJ, DM}; pg8::StaticOrder S; S.init(MTOK, NPROJ, F.G, (int)blockIdx.x); pg8::EpiBf16 E{PROJ, NPROJ};
            pg8::gemm_phase<pg8::EpiBf16, pg8::StaticOrder, true, true>(F.lds + RING_OFF, g, S, E, F.wave); GRID_BAR(); }
        if (IN(2)) { ph_mix1(F, l); GRID_BAR(); }
        if (IN(3)) { ph_select(F, l); GRID_BAR(); }
        if (IN(4)) { ph_mix2(F, l); GRID_BAR(); }
        if (IN(5)) { ph_mix3(F, l); GRID_BAR(); }
        if (IN(6)) { pg8::Gemm g{H, WOUT, MTOK, DM, DM}; pg8::StaticOrder S; S.init(MTOK, DM, F.G, (int)blockIdx.x); pg8::EpiResF32 E{xin, F.out, DM};
            pg8::gemm_phase<pg8::EpiResF32, pg8::StaticOrder, true, true>(F.lds + RING_OFF, g, S, E, F.wave); GRID_BAR(); }
        if (IN(7)) { ph_norm(F, F.out, F.inp(I_NFFN) + (size_t)l * DM); GRID_BAR(); }
        if (IN(8)) { pg8::Gemm g{H, WGU, MTOK, NGU, DM}; pg8::StaticOrder S; S.init(MTOK, NGU, F.G, (int)blockIdx.x); pg8::EpiSwiGLU E{PROJ, DFF};
            pg8::gemm_phase<pg8::EpiSwiGLU, pg8::StaticOrder, true, true>(F.lds + RING_OFF, g, S, E, F.wave); GRID_BAR(); }
        if (IN(9)) { pg8::Gemm g{PROJ, WDN, MTOK, DM, DFF}; pg8::StaticOrder S; S.init(MTOK, DM, F.G, (int)blockIdx.x); pg8::EpiResF32 E{F.out, F.out, DM};
            pg8::gemm_phase<pg8::EpiResF32, pg8::StaticOrder, true, true>(F.lds + RING_OFF, g, S, E, F.wave); if (l + 1 < args.l_hi) GRID_BAR(); }
#undef IN
    }
}

extern "C" void kernel_launch(void* const* d_in, const int* in_sizes, int n_in, void* d_out, int out_size, void* d_ws, size_t ws_size, hipStream_t stream) {
    static int grid = 0;
    if (grid == 0) {
        if (n_in != 19 || in_sizes[0] != MTOK * DM || out_size != MTOK * DM || ws_size < WS_END) { fprintf(stderr, "kernel_launch: unexpected shapes (n_in %d, in0 %d, out %d, ws %zu); nothing launched\n", n_in, n_in > 0 ? in_sizes[0] : -1, out_size, ws_size); grid = -1; return; }
        int dev = 0, cus = 0;
        if (hipGetDevice(&dev) != hipSuccess || hipDeviceGetAttribute(&cus, hipDeviceAttributeMultiprocessorCount, dev) != hipSuccess) { grid = -1; return; }
        if (hipFuncSetAttribute((const void*)trunk_fwd, hipFuncAttributeMaxDynamicSharedMemorySize, LDS_BYTES) != hipSuccess) { fprintf(stderr, "kernel_launch: hipFuncSetAttribute failed\n"); grid = -1; return; }
        int per_cu = 0;
        if (hipOccupancyMaxActiveBlocksPerMultiprocessor(&per_cu, (const void*)trunk_fwd, NWAVES * 64, LDS_BYTES) != hipSuccess || per_cu < 1) fprintf(stderr, "kernel_launch: occupancy query reports %d\n", per_cu);
        (void)hipGetLastError();
        grid = cus;
    }
    if (grid < 0) return;
    if (hipMemsetAsync((char*)d_ws + WS_CTL, 0, CTL_ZERO_BYTES, stream) != hipSuccess) return;
    Args a{};
    for (int i = 0; i < 19; ++i) a.in[i] = (const GAS float*)d_in[i];
    a.out = (GAS float*)d_out; a.ws = (GAS unsigned char*)d_ws;
#if MK_ONE_LAUNCH
    a.l_lo = 0; a.l_hi = DEPTH; a.ph_lo = 0; a.ph_hi = NPHASE;
    hipLaunchKernelGGL(trunk_fwd, dim3(grid), dim3(NWAVES * 64), LDS_BYTES, stream, a);
#else
    for (int l = 0; l < DEPTH; ++l)
        for (int ph = 0; ph < NPHASE; ++ph) { a.l_lo = l; a.l_hi = l + 1; a.ph_lo = ph; a.ph_hi = ph + 1;
            hipLaunchKernelGGL(trunk_fwd, dim3(grid), dim3(NWAVES * 64), LDS_BYTES, stream, a); }
#endif
}
```
